# Optimizing an MI355X kernel written in HIP

```python
import jax, jax.numpy as jnp
from jax import lax
import numpy as np

D_MODEL = 1024
BATCH = 8
SEQ = 4096
DEPTH = 1

HEAD_DIM = 64
GRID_W = 64
NA_HEADS = 8
NA_WIN_ROWS = 8
NA_WIN_COLS = 16
NA_QBLOCK_COLS = 16
NA_KBLOCK_COLS = 32
DIL_GROUPS = ((128, 1), (512, 4), (2048, 16))
DIL_HEADS_PER_GROUP = 4
DIL_HEADS = DIL_HEADS_PER_GROUP * len(DIL_GROUPS)
NA_WIDTH = NA_HEADS * HEAD_DIM
DIL_WIDTH = DIL_HEADS * HEAD_DIM
DIL_OUT_WIDTH = DIL_HEADS_PER_GROUP * HEAD_DIM
IN_WIDTHS = (NA_WIDTH, NA_WIDTH, NA_WIDTH, DIL_WIDTH, DIL_WIDTH, DIL_WIDTH, D_MODEL, D_MODEL)
IN_WIDTH = sum(IN_WIDTHS)
D_FF = 4 * D_MODEL
PLE_DIM = 256
ROPE_THETA = 10000.0
RMS_EPS = 1e-6
NEG_INF = -1e30

kernel_name = "hybrid_na_dilated_gated_encoder"


def rms_norm(x, g):
    xf = x.astype(jnp.float32)
    y = xf * lax.rsqrt(jnp.mean(xf * xf, axis=-1, keepdims=True) + RMS_EPS)
    return (y * g.astype(jnp.float32)).astype(x.dtype)


def rotary(x, positions):
    half = HEAD_DIM // 2
    inv_freq = ROPE_THETA ** (-jnp.arange(half, dtype=jnp.float32) / half)
    ang = positions.astype(jnp.float32)[:, None, :, None] * inv_freq
    cos, sin = jnp.cos(ang), jnp.sin(ang)
    xf = x.astype(jnp.float32)
    x1, x2 = xf[..., :half], xf[..., half:]
    return jnp.concatenate([x1 * cos - x2 * sin, x2 * cos + x1 * sin], axis=-1).astype(x.dtype)


def neighborhood_attention(q, k, v, rpb):
    b, h, s, dh = q.shape
    rows = s // GRID_W
    wr = min(NA_WIN_ROWS, rows)
    n_cb = GRID_W // NA_QBLOCK_COLS
    r = np.arange(rows)
    rs = np.clip(r - wr // 2, 0, rows - wr)
    row_idx = rs[:, None] + np.arange(wr)[None, :]
    row_off = row_idx - r[:, None] + (NA_WIN_ROWS - 1)
    c = np.arange(GRID_W)
    cs = np.clip(c - NA_WIN_COLS // 2, 0, GRID_W - NA_WIN_COLS)
    cb = np.arange(n_cb)
    kc0 = np.clip(cb * NA_QBLOCK_COLS - NA_WIN_COLS // 2, 0, GRID_W - NA_KBLOCK_COLS)
    col_idx = kc0[:, None] + np.arange(NA_KBLOCK_COLS)[None, :]
    qcol = cb[:, None] * NA_QBLOCK_COLS + np.arange(NA_QBLOCK_COLS)[None, :]
    kcol = col_idx[:, None, :]
    qs = cs[qcol][:, :, None]
    col_valid = (kcol >= qs) & (kcol < qs + NA_WIN_COLS)
    col_off = np.clip(kcol - qcol[:, :, None], -(NA_WIN_COLS - 1), NA_WIN_COLS - 1) + (NA_WIN_COLS - 1)
    bias = jnp.take(rpb[:, row_off].astype(jnp.float32), col_off, axis=-1)
    bias = jnp.where(col_valid, bias, NEG_INF).transpose(0, 1, 3, 4, 2, 5)

    qg = (q * (dh ** -0.5)).reshape(b, h, rows, n_cb, NA_QBLOCK_COLS, dh)
    kc = jnp.take(k.reshape(b, h, rows, GRID_W, dh), col_idx, axis=3)
    vc = jnp.take(v.reshape(b, h, rows, GRID_W, dh), col_idx, axis=3)
    scores = jnp.stack(
        [jnp.einsum('bhrcqd,bhrckd->bhrcqk', qg, jnp.take(kc, row_idx[:, i], axis=2)).astype(jnp.float32)
         for i in range(wr)], axis=-2)
    scores = scores + bias[None]
    probs = jax.nn.softmax(scores.reshape(*scores.shape[:-2], wr * NA_KBLOCK_COLS), axis=-1)
    probs = probs.reshape(scores.shape).astype(v.dtype)
    out = jnp.einsum('bhrcqk,bhrckd->bhrcqd', probs[..., 0, :], jnp.take(vc, row_idx[:, 0], axis=2))
    for i in range(1, wr):
        out = out + jnp.einsum('bhrcqk,bhrckd->bhrcqd', probs[..., i, :], jnp.take(vc, row_idx[:, i], axis=2))
    return out.reshape(b, h, s, dh)


def banded_attention(q, k, v, radius):
    *lead, L, dh = q.shape
    blk = radius
    nb = -(-L // blk)
    lp = nb * blk
    nlead = len(lead)
    qb = jnp.pad(q, [(0, 0)] * nlead + [(0, lp - L), (0, 0)]).reshape(*lead, nb, blk, dh)

    def band(t):
        tb = jnp.pad(t, [(0, 0)] * nlead + [(blk, lp - L + blk), (0, 0)]).reshape(*lead, nb + 2, blk, dh)
        return jnp.concatenate([tb[..., :-2, :, :], tb[..., 1:-1, :, :], tb[..., 2:, :, :]], axis=-2)

    kb, vb = band(k), band(v)
    s = jnp.einsum('...nqd,...nkd->...nqk', qb, kb).astype(jnp.float32) * (dh ** -0.5)
    qi = np.arange(lp).reshape(nb, blk)[:, :, None]
    kj = np.arange(nb)[:, None, None] * blk - blk + np.arange(3 * blk)[None, None, :]
    valid = (kj >= 0) & (kj < L) & (np.abs(qi - kj) <= radius)
    s = jnp.where(valid, s, NEG_INF)
    lse = jax.nn.logsumexp(s, axis=-1)
    pr = jnp.exp(s - lse[..., None]).astype(v.dtype)
    o = jnp.einsum('...nqk,...nkd->...nqd', pr, vb)
    return o.reshape(*lead, lp, dh)[..., :L, :], lse.reshape(*lead, lp)[..., :L]


def dilated_attention(q, k, v):
    b, _, s, dh = q.shape
    hg = DIL_HEADS_PER_GROUP
    outs, lses = [], []
    for g, (window, dil) in enumerate(DIL_GROUPS):
        radius = window // (2 * dil)

        def split(t):
            return t[:, g * hg:(g + 1) * hg].reshape(b, hg, s // dil, dil, dh).swapaxes(2, 3)

        o, lse = banded_attention(split(q), split(k), split(v), radius)
        outs.append(o.swapaxes(2, 3).reshape(b, hg, s, dh))
        lses.append(lse.swapaxes(2, 3).reshape(b, hg, s))
    w = jax.nn.softmax(jnp.stack(lses), axis=0).astype(q.dtype)
    return jnp.einsum('gbhs,gbhsd->bhsd', w, jnp.stack(outs))


def setup_inputs(seed: int = 0) -> dict:
    key = jax.random.key(seed)
    ks = jax.random.split(key, 20)
    f32 = jnp.float32

    def nrm(k, shape, fan_in):
        return jax.random.normal(k, shape, f32) * (fan_in ** -0.5)

    def gain(k, shape):
        return 1.0 + 0.01 * jax.random.normal(k, shape, f32)

    return {
        "x": jax.random.normal(ks[0], (BATCH, SEQ, D_MODEL), f32),
        "p": jax.random.normal(ks[1], (DEPTH, BATCH, SEQ, PLE_DIM), f32),
        "positions": (jnp.arange(SEQ, dtype=jnp.int32)[None, :]
                      + jax.random.randint(ks[2], (BATCH, 1), 0, 1024, dtype=jnp.int32)),
        "g_mix": gain(ks[3], (DEPTH, D_MODEL)),
        "w_in": nrm(ks[4], (DEPTH, D_MODEL, IN_WIDTH), D_MODEL),
        "rpb": 0.02 * jax.random.normal(ks[5], (DEPTH, NA_HEADS, 2 * NA_WIN_ROWS - 1, 2 * NA_WIN_COLS - 1), f32),
        "w_branch_na": nrm(ks[6], (DEPTH, NA_WIDTH, D_MODEL), NA_WIDTH),
        "w_branch_dil": nrm(ks[7], (DEPTH, DIL_OUT_WIDTH, D_MODEL), DIL_OUT_WIDTH),
        "w_out": nrm(ks[8], (DEPTH, D_MODEL, D_MODEL), D_MODEL),
        "g_mlp": gain(ks[9], (DEPTH, D_MODEL)),
        "w_up": nrm(ks[10], (DEPTH, D_MODEL, D_FF), D_MODEL),
        "w_down": nrm(ks[11], (DEPTH, D_FF, D_MODEL), D_FF),
        "g_ple": gain(ks[12], (DEPTH, D_MODEL)),
        "w_ple_gate": nrm(ks[13], (DEPTH, D_MODEL, D_MODEL), D_MODEL),
        "w_ple_proj": nrm(ks[14], (DEPTH, PLE_DIM, D_MODEL), PLE_DIM),
        "g_final": gain(ks[15], (D_MODEL,)),
    }


def reference(x, p, positions, g_mix, w_in, rpb, w_branch_na, w_branch_dil, w_out, g_mlp, w_up, w_down,
              g_ple, w_ple_gate, w_ple_proj, g_final):
    b, s, _ = x.shape
    split_points = [int(v) for v in np.cumsum(IN_WIDTHS)[:-1]]

    def heads(t, n):
        return t.reshape(b, s, n, HEAD_DIM).transpose(0, 2, 1, 3)

    def merge(t):
        return t.transpose(0, 2, 1, 3).reshape(b, s, -1)

    h = x
    for i in range(DEPTH):
        a = rms_norm(h, g_mix[i])
        qa, ka, va, qd, kd, vd, gate_na, gate_dil = jnp.split(a @ w_in[i], split_points, axis=-1)
        y_na = merge(neighborhood_attention(heads(qa, NA_HEADS), heads(ka, NA_HEADS), heads(va, NA_HEADS), rpb[i]))
        y_dil = merge(dilated_attention(rotary(heads(qd, DIL_HEADS), positions),
                                        rotary(heads(kd, DIL_HEADS), positions),
                                        heads(vd, DIL_HEADS)))
        mixed = (jax.nn.sigmoid(gate_na) * (y_na @ w_branch_na[i])
                 + jax.nn.sigmoid(gate_dil) * (y_dil @ w_branch_dil[i]))
        h = h + mixed @ w_out[i]
        c = rms_norm(h, g_mlp[i])
        h = h + jnp.square(jax.nn.relu(c @ w_up[i])) @ w_down[i]
        e = rms_norm(h, g_ple[i])
        h = h + jax.nn.sigmoid(e @ w_ple_gate[i]) * (p[i] @ w_ple_proj[i])
    return rms_norm(h, g_final)
```

```cpp
#include <hip/hip_runtime.h>
#include <cstdio>
#include <cstdint>
#include <cmath>

#ifndef MK_N_LAUNCHES
#define MK_N_LAUNCHES 9
#endif

namespace pg8 {
#define PG8_LAS __attribute__((address_space(3)))
typedef unsigned short bf16_t;
typedef short bf16x8 __attribute__((ext_vector_type(8)));
typedef float f32x4 __attribute__((ext_vector_type(4)));
typedef unsigned u32x4 __attribute__((ext_vector_type(4)));
constexpr int BM = 256, BK = 64, HALF = 128, HTB = HALF * BK * 2  , STAGE_BYTES = 8 * HTB, NXCD = 8, WGM = 8;

__host__ __device__ __forceinline__ int lds_byte(int r, int c) { const int st = (r >> 4) * 2 + (c >> 5), rr = r & 15, cc = c & 31, ob = rr * 64 + cc * 2; return st * 1024 + (ob ^ (((ob >> 9) & 1) << 5)); }
__host__ __device__ __forceinline__ void stage_rc(int b, int& R, int& C) { const int st = b / 1024, sb = b % 1024, swz = sb ^ (((sb >> 9) & 1) << 5); R = (st >> 1) * 16 + swz / 64; C = (st & 1) * 32 + (swz % 64) / 2; }
__host__ __device__ __forceinline__ int perm32(int rho) { const int n = rho >> 4, i = rho & 15; return 8 * (i >> 2) + 4 * n + (i & 3); }

struct Unit { int pm, pn; };
struct Gemm { const bf16_t* A; const bf16_t* Bt; int M, N, K, lda; };

struct StaticOrder {
    int nM, nN, nwg, G, c;
    __host__ __device__ void init(int M, int N, int G_, int c_) { nM = M / BM; nN = N / BM; nwg = nM * nN; G = G_; c = c_; }
    __host__ __device__ bool next(int i, Unit& u) const {
        const long L = (long)i * G + c; if (L >= nwg) return false;
        int wgid = (int)L; { const int q = nwg / NXCD, r = nwg % NXCD, xcd = wgid % NXCD, off = wgid / NXCD; wgid = (xcd < r ? xcd * (q + 1) : r * (q + 1) + (xcd - r) * q) + off; }
        const int nig = WGM * nN, gid = wgid / nig, fm = gid * WGM, gsz = (nM - fm) < WGM ? (nM - fm) : WGM;
        u.pm = fm + ((wgid % nig) % gsz); u.pn = (wgid % nig) / gsz; return true;
    }
    __device__ __forceinline__ void a_ready(const Unit&) const {}
    __device__ __forceinline__ void done(const Unit&) const {}
};

__device__ __forceinline__ int lane_id_now() { int l; asm volatile("v_mbcnt_lo_u32_b32 %0, -1, 0\n\tv_mbcnt_hi_u32_b32 %0, -1, %0" : "=v"(l)); return l; }
typedef float f32x2_t __attribute__((ext_vector_type(2))); typedef __bf16 bf16x2_t __attribute__((ext_vector_type(2)));
__device__ __forceinline__ unsigned cvt_pk_bf16(float lo, float hi) { f32x2_t v = {lo, hi}; bf16x2_t b = __builtin_convertvector(v, bf16x2_t); return __builtin_bit_cast(unsigned, b); }
__device__ __forceinline__ u32x4 pack8(const f32x4 a, const f32x4 b) { u32x4 w; w.x = cvt_pk_bf16(a[0], a[1]); w.y = cvt_pk_bf16(a[2], a[3]); w.z = cvt_pk_bf16(b[0], b[1]); w.w = cvt_pk_bf16(b[2], b[3]); return w; }
__device__ __forceinline__ float bf_lo(unsigned u) { return __uint_as_float(u << 16); }
__device__ __forceinline__ float bf_hi(unsigned u) { return __uint_as_float(u & 0xffff0000u); }
__device__ __forceinline__ void unpack8(const u32x4 w, f32x4& a, f32x4& b) { a = (f32x4){bf_lo(w.x), bf_hi(w.x), bf_lo(w.y), bf_hi(w.y)}; b = (f32x4){bf_lo(w.z), bf_hi(w.z), bf_lo(w.w), bf_hi(w.w)}; }

template <class Epi, class Sched, bool ALIGN_EPI = false, bool SP2 = false>
__device__ __forceinline__ void gemm_phase(PG8_LAS unsigned char* lds, const Gemm g, const Sched& S, const Epi& E, const int wid) {
    const int lane = lane_id_now(), tid = wid * 64 + lane, wr = wid >> 2, wc = wid & 3, fr = lane & 15, fq = lane >> 4;
    const int K = g.K, nt = K / BK, lda = g.lda;
    unsigned voffA[2], voffB[2];
#pragma unroll
    for (int i = 0; i < 2; ++i) { int R, C; stage_rc(tid * 16 + i * 8192, R, C); const int Rb = Epi::PERM ? ((R & ~31) + perm32(R & 31)) : R;
        voffA[i] = (unsigned)(R * lda + C) * 2u; voffB[i] = (unsigned)(Rb * K + C) * 2u; }
    const size_t kstep = (size_t)(BK * 2);
    const size_t hstepA = (size_t)HALF * lda * 2, hstepB = (size_t)HALF * K * 2;
    const size_t tstepA = 2 * hstepA, tstepB = 2 * hstepB;
    const unsigned ldsw = (unsigned)wid * 1024u;
    const int aoff = lds_byte(wr * 64 + fr, fq * 8), boff = lds_byte(wc * 32 + fr, fq * 8);
#define PG8_SA(b, h) (((b) * 2 + (h)) * HTB)
#define PG8_SB(b, h) ((4 + (b) * 2 + (h)) * HTB)
#define PG8_STAGE(bufoff, gbase, voff) do { _Pragma("unroll") for (int _i = 0; _i < 2; ++_i) \
        __builtin_amdgcn_global_load_lds((const unsigned*)((const char*)(gbase) + (voff)[_i]), (PG8_LAS unsigned*)(lds + (bufoff) + ldsw + _i * 8192), 16, 0, 0); } while (0)
#define PG8_LDA(dst, b, h) do { _Pragma("unroll") for (int m = 0; m < 4; ++m) _Pragma("unroll") for (int k = 0; k < 2; ++k) dst[m][k] = *(const PG8_LAS bf16x8*)(lds + PG8_SA(b, h) + aoff + m * 2048 + k * 1024); } while (0)
#define PG8_LDB(dst, b, h) do { _Pragma("unroll") for (int n = 0; n < 2; ++n) _Pragma("unroll") for (int k = 0; k < 2; ++k) dst[n][k] = *(const PG8_LAS bf16x8*)(lds + PG8_SB(b, h) + boff + n * 2048 + k * 1024); } while (0)
#define PG8_MMA(ai, bj, At, Bt) do { __builtin_amdgcn_s_setprio(1); _Pragma("unroll") for (int m = 0; m < 4; ++m) _Pragma("unroll") for (int n = 0; n < 2; ++n) _Pragma("unroll") for (int k = 0; k < 2; ++k) \
        acc[ai][bj][m][n] = __builtin_amdgcn_mfma_f32_16x16x32_bf16(Bt[n][k], At[m][k], acc[ai][bj][m][n], 0, 0, 0); __builtin_amdgcn_s_setprio(0); } while (0)
#define PG8_WAIT_V(n) asm volatile("s_waitcnt vmcnt(" #n ")" ::: "memory")
#define PG8_WAIT_L(n) asm volatile("s_waitcnt lgkmcnt(" #n ")" ::: "memory")
#define PG8_BAR __builtin_amdgcn_s_barrier()
#define PG8_SCHED __builtin_amdgcn_sched_barrier(0)
    Unit cur, nxt; int ui = 0;
    if (!S.next(0, cur)) return;
    f32x4 acc[2][2][4][2];
#pragma unroll
    for (int a = 0; a < 2; ++a)
#pragma unroll
        for (int b = 0; b < 2; ++b)
#pragma unroll
            for (int m = 0; m < 4; ++m)
#pragma unroll
                for (int n = 0; n < 2; ++n) acc[a][b][m][n] = (f32x4){0.f, 0.f, 0.f, 0.f};
    bf16x8 At[4][2], B0[2][2], B1[2][2];
    const char* cA = (const char*)g.A + (size_t)cur.pm * tstepA; const char* cB = (const char*)g.Bt + (size_t)cur.pn * tstepB;
    S.a_ready(cur);
    if constexpr (SP2) {
        PG8_STAGE(PG8_SB(0, 0), cB, voffB); PG8_STAGE(PG8_SB(0, 1), cB + hstepB, voffB); PG8_STAGE(PG8_SA(0, 0), cA, voffA); PG8_STAGE(PG8_SA(0, 1), cA + hstepA, voffA);
        if (wr == 1) PG8_BAR;
        PG8_WAIT_V(2); PG8_BAR;
        PG8_STAGE(PG8_SB(1, 0), cB + kstep, voffB); PG8_STAGE(PG8_SA(1, 0), cA + kstep, voffA); PG8_STAGE(PG8_SB(1, 1), cB + hstepB + kstep, voffB);
        PG8_WAIT_V(6); PG8_BAR;
    } else {
        PG8_STAGE(PG8_SB(0, 0), cB, voffB); PG8_STAGE(PG8_SA(0, 0), cA, voffA); PG8_STAGE(PG8_SB(0, 1), cB + hstepB, voffB); PG8_STAGE(PG8_SA(0, 1), cA + hstepA, voffA);
        if (wr == 1) PG8_BAR;
        PG8_WAIT_V(4); PG8_BAR;
        PG8_STAGE(PG8_SB(1, 0), cB + kstep, voffB); PG8_STAGE(PG8_SA(1, 0), cA + kstep, voffA); PG8_STAGE(PG8_SB(1, 1), cB + hstepB + kstep, voffB);
        PG8_WAIT_V(6); PG8_BAR;
    }
    for (;;) {
        const bool has_next = S.next(ui + 1, nxt);
        const char* nA = has_next ? (const char*)g.A + (size_t)nxt.pm * tstepA : cA; const char* nB = has_next ? (const char*)g.Bt + (size_t)nxt.pn * tstepB : cB;
        for (int t = 0; t < nt; t += 2) {
            if constexpr (Epi::HAS_MID) { if (t == Epi::MID_T) E.mid(acc, cur, wr, wc, fr, fq); }
            const bool last = (t == nt - 2);
            const char* a1 = cA + (size_t)(t + 1) * kstep;
            const char* a2 = last ? nA : cA + (size_t)(t + 2) * kstep; const char* b2 = last ? nB : cB + (size_t)(t + 2) * kstep;
            const char* a3 = a2 + kstep; const char* b3 = b2 + kstep;
            if (last && has_next) S.a_ready(nxt);
            if constexpr (SP2) {
            PG8_LDB(B0, 0, 0); PG8_LDB(B1, 0, 1); PG8_SCHED; PG8_LDA(At, 0, 0); PG8_STAGE(PG8_SA(1, 1), a1 + hstepA, voffA);
            PG8_WAIT_V(8); PG8_WAIT_L(0); PG8_BAR; PG8_MMA(0, 0, At, B0); PG8_MMA(0, 1, At, B1); PG8_BAR; PG8_SCHED;
            PG8_LDA(At, 0, 1); PG8_STAGE(PG8_SB(0, 0), b2, voffB); PG8_STAGE(PG8_SB(0, 1), b2 + hstepB, voffB); PG8_STAGE(PG8_SA(0, 0), a2, voffA);
            PG8_WAIT_V(8); PG8_WAIT_L(0); PG8_BAR; PG8_MMA(1, 0, At, B0); PG8_MMA(1, 1, At, B1); PG8_BAR; PG8_SCHED;
            PG8_LDB(B0, 1, 0); PG8_LDB(B1, 1, 1); PG8_SCHED; PG8_LDA(At, 1, 0); PG8_STAGE(PG8_SA(0, 1), a2 + hstepA, voffA);
            PG8_WAIT_V(8); PG8_WAIT_L(0); PG8_BAR; PG8_MMA(0, 0, At, B0); PG8_MMA(0, 1, At, B1); PG8_BAR; PG8_SCHED;
            PG8_LDA(At, 1, 1); PG8_STAGE(PG8_SB(1, 0), b3, voffB); PG8_STAGE(PG8_SB(1, 1), b3 + hstepB, voffB); PG8_STAGE(PG8_SA(1, 0), a3, voffA);
            PG8_WAIT_V(8); PG8_WAIT_L(0); PG8_BAR; PG8_MMA(1, 0, At, B0); PG8_MMA(1, 1, At, B1); PG8_BAR; PG8_SCHED;
            } else {
            PG8_LDB(B0, 0, 0); PG8_SCHED; PG8_LDA(At, 0, 0); PG8_STAGE(PG8_SA(1, 1), a1 + hstepA, voffA);
            PG8_WAIT_L(8); PG8_BAR; PG8_WAIT_L(0); PG8_MMA(0, 0, At, B0); PG8_BAR; PG8_SCHED;
            PG8_LDB(B1, 0, 1); PG8_STAGE(PG8_SB(0, 0), b2, voffB);
            PG8_BAR; PG8_WAIT_L(0); PG8_MMA(0, 1, At, B1); PG8_BAR;
            PG8_LDA(At, 0, 1); PG8_STAGE(PG8_SA(0, 0), a2, voffA);
            PG8_BAR; PG8_WAIT_L(0); PG8_MMA(1, 0, At, B0); PG8_BAR; PG8_SCHED;
            PG8_STAGE(PG8_SB(0, 1), b2 + hstepB, voffB);
            PG8_WAIT_V(6); PG8_BAR; PG8_MMA(1, 1, At, B1); PG8_BAR;
            PG8_LDB(B0, 1, 0); PG8_SCHED; PG8_LDA(At, 1, 0); PG8_STAGE(PG8_SA(0, 1), a2 + hstepA, voffA);
            PG8_WAIT_L(8); PG8_BAR; PG8_WAIT_L(0); PG8_MMA(0, 0, At, B0); PG8_BAR; PG8_SCHED;
            PG8_LDB(B1, 1, 1); PG8_STAGE(PG8_SB(1, 0), b3, voffB);
            PG8_BAR; PG8_WAIT_L(0); PG8_MMA(0, 1, At, B1); PG8_BAR;
            PG8_LDA(At, 1, 1); PG8_STAGE(PG8_SA(1, 0), a3, voffA);
            PG8_BAR; PG8_WAIT_L(0); PG8_MMA(1, 0, At, B0); PG8_BAR; PG8_SCHED;
            PG8_STAGE(PG8_SB(1, 1), b3 + hstepB, voffB);
            PG8_WAIT_V(6); PG8_BAR; PG8_MMA(1, 1, At, B1); PG8_BAR;
            }
        }
        if constexpr (ALIGN_EPI) { if (wr == 0) PG8_BAR; }
        E(acc, cur, wr, wc, fr, fq); S.done(cur);
        if (!has_next) break;
#pragma unroll
        for (int a = 0; a < 2; ++a)
#pragma unroll
            for (int b = 0; b < 2; ++b)
#pragma unroll
                for (int m = 0; m < 4; ++m)
#pragma unroll
                    for (int n = 0; n < 2; ++n) acc[a][b][m][n] = (f32x4){0.f, 0.f, 0.f, 0.f};
        cur = nxt; cA = nA; cB = nB; ++ui;
        if constexpr (ALIGN_EPI) { if (wr == 1) PG8_BAR; }
    }
    PG8_WAIT_V(0);
    if constexpr (!ALIGN_EPI) { if (wr == 0) PG8_BAR; }
    PG8_BAR;
#undef PG8_SA
#undef PG8_SB
#undef PG8_STAGE
#undef PG8_LDA
#undef PG8_LDB
#undef PG8_MMA
#undef PG8_WAIT_V
#undef PG8_WAIT_L
#undef PG8_BAR
#undef PG8_SCHED
}
}

#ifndef PG8_SP2
#define PG8_SP2 true
#endif
#ifndef PG8_ALIGN
#define PG8_ALIGN true
#endif

constexpr int NWAVES = 8;
constexpr int N_LAUNCHES = MK_N_LAUNCHES;
constexpr int PER_PHASE = 9;
constexpr int BATCH = 8, SEQ = 4096, DM = 1024, M = BATCH * SEQ;
constexpr int NQKV = 3840, NGATE = 2048, NIN = 5888, DFF = 4096, PLE = 256, HPW = 1280, YW = 768;
constexpr float RMS_EPS = 1e-6f;

constexpr size_t MiB = 1u << 20;
constexpr size_t WS_CTL = 0, CTL_ZERO_BYTES = 1 * MiB;
constexpr size_t WS_WIN = 1 * MiB, WS_WC1 = 13 * MiB, WS_WO = 15 * MiB, WS_WUP = 17 * MiB, WS_WDN = 25 * MiB, WS_WC2 = 33 * MiB;
constexpr size_t WS_CS = 36 * MiB;
constexpr size_t WS_SSQ = 44 * MiB;
constexpr size_t WS_HP = 50 * MiB;
constexpr size_t WS_QKV = 130 * MiB;
constexpr size_t WS_GATES = 370 * MiB;
constexpr size_t WS_MIXED = 130 * MiB;
constexpr size_t WS_U = 130 * MiB;
constexpr size_t WS_T2 = 130 * MiB;
constexpr size_t WS_END = 498 * MiB;
constexpr int CW_TMO = 0, CW_CODE = 1;
constexpr int CW_BAR = 4096;

constexpr int RING_OFF = 0, RING_BYTES = 131072;
constexpr int LDSCTL_OFF = RING_BYTES, MISC_OFF = LDSCTL_OFF + 320;
constexpr int LDS_BYTES = 147456;

#define GAS __attribute__((address_space(1)))
#define LAS __attribute__((address_space(3)))
typedef unsigned short bf16;
typedef unsigned v4u __attribute__((ext_vector_type(4)));
typedef unsigned v2u __attribute__((ext_vector_type(2)));
typedef float f32x4 __attribute__((ext_vector_type(4)));
typedef float f32x2 __attribute__((ext_vector_type(2)));
typedef GAS unsigned gu32;
#define RLX_AGENT __ATOMIC_RELAXED, __HIP_MEMORY_SCOPE_AGENT
#define LDS_WAIT() asm volatile("s_waitcnt lgkmcnt(0)" ::: "memory")
#define VM_WAIT() asm volatile("s_waitcnt vmcnt(0)" ::: "memory")
__device__ __forceinline__ unsigned f2bf(float f) { unsigned u = __builtin_bit_cast(unsigned, f); return (u + 0x7fffu + ((u >> 16) & 1u)) >> 16; }
__device__ __forceinline__ unsigned pk2(float lo, float hi) { return f2bf(lo) | (f2bf(hi) << 16); }
__device__ __forceinline__ float sigmoidf_(float x) { return __builtin_amdgcn_rcpf(1.f + __expf(-x)); }

#define XB_TMO      128
#define XB_XCNT(j)  (256  + 64 * (j))
#define XB_XSUB(j)  (1280 + 64 * (j))
#define XB_XGEN(j)  (2304 + 64 * (j))
#define XB_TOP      3328
#define XB_TOPGEN   3392
#define XCD_BAR_WORDS 3456
#define XB_SPIN_CAP (1u << 18)

__device__ __forceinline__ unsigned xb_ld(unsigned* p)              { return __hip_atomic_load(p, __ATOMIC_RELAXED, __HIP_MEMORY_SCOPE_AGENT); }
__device__ __forceinline__ unsigned xb_add(unsigned* p, unsigned v) { return __hip_atomic_fetch_add(p, v, __ATOMIC_RELAXED, __HIP_MEMORY_SCOPE_AGENT); }
__device__ __forceinline__ unsigned xb_xcc_id() { return (unsigned)__builtin_amdgcn_s_getreg((3 << 11) | 20) & 0xFu; }
#define XB_SPIN(cond, bar) do { unsigned _sp = 0; while (cond) { __builtin_amdgcn_s_sleep(1); \
    if ((++_sp & 255u) == 0u) { if (xb_ld(&(bar)[XB_TMO])) break; if (_sp > XB_SPIN_CAP) { atomicAdd(&(bar)[XB_TMO], 1u); break; } } } } while (0)

struct XcdBarrier { unsigned* bar; unsigned x; volatile LAS unsigned* st; };

__device__ __forceinline__ XcdBarrier xcd_barrier_post(unsigned* bar, volatile LAS unsigned* st) {
    XcdBarrier b; b.bar = bar; b.x = xb_xcc_id(); b.st = st;
    if (threadIdx.x == 0) (void)xb_add(&bar[XB_XCNT(b.x)], 1u);
    return b;
}
__device__ __forceinline__ void xcd_barrier_complete(unsigned* bar, unsigned x, unsigned& nloc, unsigned& nx) {
    const unsigned G = gridDim.x * gridDim.y * gridDim.z;
    unsigned sum, cnt, mine, sp = 0u;
    for (;;) {
        sum = 0u; cnt = 0u; mine = 0u;
#pragma unroll
        for (unsigned j = 0; j < 16; ++j) { const unsigned c = xb_ld(&bar[XB_XCNT(j)]); sum += c; cnt += (c > 0u) ? 1u : 0u; mine = (j == x) ? c : mine; }
        if (sum == G) break;
        __builtin_amdgcn_s_sleep(1);
        if ((++sp & 255u) == 0u) { if (xb_ld(&bar[XB_TMO])) break; if (sp > XB_SPIN_CAP) { atomicAdd(&bar[XB_TMO], 1u); break; } }
    }
    nloc = mine > 0u ? mine : 1u; nx = cnt > 0u ? cnt : 1u;
}
__device__ __forceinline__ void xcd_barrier(const XcdBarrier& b, const int wave) {
    asm volatile("s_waitcnt vmcnt(0)" ::: "memory");
    __syncthreads();
    if (wave == 0 && pg8::lane_id_now() == 0) {
        unsigned* bar = b.bar;
        __builtin_amdgcn_s_waitcnt(0);
        unsigned nloc = b.st[0], nx = b.st[1];
        if (nloc == 0u) { xcd_barrier_complete(bar, b.x, nloc, nx); b.st[0] = nloc; b.st[1] = nx; }
        const unsigned old = xb_add(&bar[XB_XSUB(b.x)], 1u);
        const unsigned gen = old / nloc;
        if (old + 1u == (gen + 1u) * nloc) {
            __builtin_amdgcn_fence(__ATOMIC_RELEASE, "agent");
            asm volatile("s_waitcnt vmcnt(0)" ::: "memory");
            const unsigned og = xb_add(&bar[XB_TOP], 1u);
            const unsigned tg = og / nx;
            if (og + 1u == (tg + 1u) * nx) xb_add(&bar[XB_TOPGEN], 1u);
            else XB_SPIN(xb_ld(&bar[XB_TOPGEN]) == tg, bar);
            __builtin_amdgcn_fence(__ATOMIC_ACQUIRE, "agent");
            xb_add(&bar[XB_XGEN(b.x)], 1u);
            asm volatile("s_waitcnt vmcnt(0)" ::: "memory");
        } else {
            XB_SPIN(xb_ld(&bar[XB_XGEN(b.x)]) == gen, bar);
            __builtin_amdgcn_fence(__ATOMIC_ACQUIRE, "agent");
            asm volatile("s_waitcnt vmcnt(0)" ::: "memory");
        }
    }
    __syncthreads();
}

using pg8::f32x4; using pg8::u32x4; using pg8::Unit; using pg8::pack8; using pg8::unpack8;
typedef f32x4 acc_t[2][2][4][2];

__device__ __forceinline__ int perm_row(int row, int sh) {
    const int t = row & (SEQ - 1);
    return (row & ~(SEQ - 1)) | ((t & ((1 << sh) - 1)) << (12 - sh)) | (t >> sh);
}

#define EPI_ROW0() unsigned rbase = (unsigned)(u.pm * 256 + wr * 64 + fr); asm volatile("" : "+v"(rbase))

struct EpiIn {
    static constexpr bool PERM = true, HAS_MID = false; static constexpr int MID_T = -1;
    bf16* QKV; bf16* GATES; const float* CS;
    __device__ __forceinline__ void mid(acc_t&, const Unit&, int, int, int, int) const {}
    __device__ __forceinline__ void operator()(const acc_t& acc, const Unit& u, int wr, int wc, int fr, int fq) const {
        const int pn = u.pn; EPI_ROW0();
        if (pn >= 15) {
            const unsigned col0 = (unsigned)((pn - 15) * 256 + wc * 32 + 8 * fq);
#pragma unroll
            for (int ai = 0; ai < 2; ++ai)
#pragma unroll
                for (int m = 0; m < 4; ++m) { const unsigned ro = (rbase + ai * 128 + m * 16) * NGATE + col0;
#pragma unroll
                    for (int bj = 0; bj < 2; ++bj) { f32x4 v0 = acc[ai][bj][m][0], v1 = acc[ai][bj][m][1];
#pragma unroll
                        for (int j = 0; j < 4; ++j) { v0[j] = sigmoidf_(v0[j]); v1[j] = sigmoidf_(v1[j]); }
                        *(u32x4*)(GATES + (ro + bj * 128)) = pack8(v0, v1); } }
        } else if (pn >= 6 && pn < 12) {
            const int g = (pn - 6) % 3, sh = 2 * g; const float sc = pn < 9 ? 0.125f : 1.f;
            const unsigned col0 = (unsigned)(pn * 256 + wc * 64 + 8 * fq);
#pragma unroll
            for (int ai = 0; ai < 2; ++ai)
#pragma unroll
                for (int m = 0; m < 4; ++m) { const unsigned row = rbase + ai * 128 + m * 16; const unsigned ro = (unsigned)perm_row((int)row, sh) * NQKV + col0;
                    const f32x4* cs = (const f32x4*)(CS + (row * 64u + 16u * fq));
                    const f32x4 c01 = cs[0], c23 = cs[1], c45 = cs[2], c67 = cs[3];
                    const float cc[8] = {c01[0], c01[2], c23[0], c23[2], c45[0], c45[2], c67[0], c67[2]};
                    const float ss[8] = {c01[1], c01[3], c23[1], c23[3], c45[1], c45[3], c67[1], c67[3]};
                    f32x4 o1[2], o2[2];
#pragma unroll
                    for (int n = 0; n < 2; ++n)
#pragma unroll
                        for (int j = 0; j < 4; ++j) { const float x1 = acc[ai][0][m][n][j], x2 = acc[ai][1][m][n][j], c = cc[4 * n + j], sn = ss[4 * n + j];
                            o1[n][j] = (x1 * c - x2 * sn) * sc; o2[n][j] = (x2 * c + x1 * sn) * sc; }
                    *(u32x4*)(QKV + ro) = pack8(o1[0], o1[1]); *(u32x4*)(QKV + (ro + 32)) = pack8(o2[0], o2[1]); }
        } else {
            const float sc = pn < 2 ? 0.125f : 1.f; const int sh = pn >= 12 ? 2 * (pn - 12) : 0;
            const unsigned col0 = (unsigned)(pn * 256 + wc * 32 + 8 * fq);
#pragma unroll
            for (int ai = 0; ai < 2; ++ai)
#pragma unroll
                for (int m = 0; m < 4; ++m) { const unsigned row = rbase + ai * 128 + m * 16; const unsigned ro = (unsigned)perm_row((int)row, sh) * NQKV + col0;
#pragma unroll
                    for (int bj = 0; bj < 2; ++bj) *(u32x4*)(QKV + (ro + bj * 128)) = pack8(acc[ai][bj][m][0] * sc, acc[ai][bj][m][1] * sc); }
        }
    }
};

struct EpiMix {
    static constexpr bool PERM = true, HAS_MID = true; static constexpr int MID_T = 8;
    const bf16* GATES; bf16* MIXED;
    __device__ __forceinline__ void mid(acc_t& acc, const Unit& u, int wr, int wc, int fr, int fq) const {
        EPI_ROW0(); const unsigned col0 = (unsigned)(u.pn * 256 + wc * 32 + 8 * fq);
#pragma unroll
        for (int ai = 0; ai < 2; ++ai)
#pragma unroll
            for (int m = 0; m < 4; ++m) { const unsigned ro = (rbase + ai * 128 + m * 16) * NGATE + col0;
#pragma unroll
                for (int bj = 0; bj < 2; ++bj) { f32x4 a0, a1, b0, b1; unpack8(*(const u32x4*)(GATES + (ro + bj * 128)), a0, a1); unpack8(*(const u32x4*)(GATES + (ro + bj * 128 + 1024)), b0, b1);
#pragma unroll
                    for (int j = 0; j < 4; ++j) { acc[ai][bj][m][0][j] *= a0[j] * __builtin_amdgcn_rcpf(fmaxf(b0[j], 1e-30f)); acc[ai][bj][m][1][j] *= a1[j] * __builtin_amdgcn_rcpf(fmaxf(b1[j], 1e-30f)); } } }
    }
    __device__ __forceinline__ void operator()(const acc_t& acc, const Unit& u, int wr, int wc, int fr, int fq) const {
        EPI_ROW0(); const unsigned col0 = (unsigned)(u.pn * 256 + wc * 32 + 8 * fq);
#pragma unroll
        for (int ai = 0; ai < 2; ++ai)
#pragma unroll
            for (int m = 0; m < 4; ++m) { const unsigned row = rbase + ai * 128 + m * 16; const unsigned go = row * NGATE + 1024 + col0, oo = row * DM + col0;
#pragma unroll
                for (int bj = 0; bj < 2; ++bj) { f32x4 b0, b1; unpack8(*(const u32x4*)(GATES + (go + bj * 128)), b0, b1);
                    *(u32x4*)(MIXED + (oo + bj * 128)) = pack8(acc[ai][bj][m][0] * b0, acc[ai][bj][m][1] * b1); } }
    }
};

struct EpiRes {
    static constexpr bool PERM = true, HAS_MID = false; static constexpr int MID_T = -1;
    const float* base; float* out; bf16* HB; float* ssq;
    __device__ __forceinline__ void mid(acc_t&, const Unit&, int, int, int, int) const {}
    __device__ __forceinline__ void operator()(const acc_t& acc, const Unit& u, int wr, int wc, int fr, int fq) const {
        EPI_ROW0(); const unsigned col0 = (unsigned)(u.pn * 256 + wc * 32 + 8 * fq);
#pragma unroll
        for (int ai = 0; ai < 2; ++ai)
#pragma unroll
            for (int m = 0; m < 4; ++m) { const unsigned row = rbase + ai * 128 + m * 16; float s = 0.f;
#pragma unroll
                for (int bj = 0; bj < 2; ++bj) { const unsigned off = row * DM + col0 + bj * 128;
                    const f32x4 v0 = *(const f32x4*)(base + off) + acc[ai][bj][m][0], v1 = *(const f32x4*)(base + (off + 4)) + acc[ai][bj][m][1];
                    *(f32x4*)(out + off) = v0; *(f32x4*)(out + (off + 4)) = v1;
                    s += (v0[0] * v0[0] + v0[1] * v0[1]) + (v0[2] * v0[2] + v0[3] * v0[3]) + (v1[0] * v1[0] + v1[1] * v1[1]) + (v1[2] * v1[2] + v1[3] * v1[3]);
                    *(u32x4*)(HB + (row * HPW + col0 + bj * 128)) = pack8(v0, v1); }
                s += __shfl_xor(s, 16); s += __shfl_xor(s, 32);
                if (fq == 0) ssq[row * 16 + u.pn * 4 + wc] = s; }
    }
};

__device__ __forceinline__ float row_rstd(const float* ssq, unsigned row) {
    const f32x4* p = (const f32x4*)(ssq + row * 16u); const f32x4 a = p[0], b = p[1], c = p[2], d = p[3];
    const float s = ((a[0] + a[1]) + (a[2] + a[3])) + ((b[0] + b[1]) + (b[2] + b[3])) + ((c[0] + c[1]) + (c[2] + c[3])) + ((d[0] + d[1]) + (d[2] + d[3]));
    return 1.0f / sqrtf(s * (1.0f / DM) + RMS_EPS);
}

struct EpiUp {
    static constexpr bool PERM = true, HAS_MID = false; static constexpr int MID_T = -1;
    const float* ssq; bf16* U;
    __device__ __forceinline__ void mid(acc_t&, const Unit&, int, int, int, int) const {}
    __device__ __forceinline__ void operator()(const acc_t& acc, const Unit& u, int wr, int wc, int fr, int fq) const {
        EPI_ROW0(); const unsigned col0 = (unsigned)(u.pn * 256 + wc * 32 + 8 * fq);
#pragma unroll
        for (int ai = 0; ai < 2; ++ai)
#pragma unroll
            for (int m = 0; m < 4; ++m) { const unsigned row = rbase + ai * 128 + m * 16; const float r = row_rstd(ssq, row); const unsigned oo = row * DFF + col0;
#pragma unroll
                for (int bj = 0; bj < 2; ++bj) { f32x4 v0 = acc[ai][bj][m][0] * r, v1 = acc[ai][bj][m][1] * r;
#pragma unroll
                    for (int j = 0; j < 4; ++j) { const float a = fmaxf(v0[j], 0.f), b = fmaxf(v1[j], 0.f); v0[j] = a * a; v1[j] = b * b; }
                    *(u32x4*)(U + (oo + bj * 128)) = pack8(v0, v1); } }
    }
};

struct EpiPle {
    static constexpr bool PERM = true, HAS_MID = true; static constexpr int MID_T = 4;
    bf16* T2; const float* ssq_in; float* out; float* ssq_out;
    __device__ __forceinline__ void mid(acc_t& acc, const Unit& u, int wr, int wc, int fr, int fq) const {
        EPI_ROW0(); const unsigned col0 = (unsigned)(u.pn * 256 + wc * 32 + 8 * fq);
#pragma unroll
        for (int ai = 0; ai < 2; ++ai)
#pragma unroll
            for (int m = 0; m < 4; ++m) { const unsigned to = (rbase + ai * 128 + m * 16) * DM + col0;
#pragma unroll
                for (int bj = 0; bj < 2; ++bj) { *(u32x4*)(T2 + (to + bj * 128)) = pack8(acc[ai][bj][m][0], acc[ai][bj][m][1]);
                    acc[ai][bj][m][0] = (f32x4){0.f, 0.f, 0.f, 0.f}; acc[ai][bj][m][1] = (f32x4){0.f, 0.f, 0.f, 0.f}; } }
    }
    __device__ __forceinline__ void operator()(const acc_t& acc, const Unit& u, int wr, int wc, int fr, int fq) const {
        EPI_ROW0(); const unsigned col0 = (unsigned)(u.pn * 256 + wc * 32 + 8 * fq);
#pragma unroll
        for (int ai = 0; ai < 2; ++ai)
#pragma unroll
            for (int m = 0; m < 4; ++m) { const unsigned row = rbase + ai * 128 + m * 16; const float r = row_rstd(ssq_in, row); float s = 0.f;
#pragma unroll
                for (int bj = 0; bj < 2; ++bj) { const unsigned off = row * DM + col0 + bj * 128;
                    f32x4 t0, t1; unpack8(*(const u32x4*)(T2 + off), t0, t1);
                    f32x4 v0 = *(const f32x4*)(out + off), v1 = *(const f32x4*)(out + (off + 4));
#pragma unroll
                    for (int j = 0; j < 4; ++j) { v0[j] += sigmoidf_(acc[ai][bj][m][0][j] * r) * t0[j]; v1[j] += sigmoidf_(acc[ai][bj][m][1][j] * r) * t1[j]; }
                    *(f32x4*)(out + off) = v0; *(f32x4*)(out + (off + 4)) = v1;
                    s += (v0[0] * v0[0] + v0[1] * v0[1]) + (v0[2] * v0[2] + v0[3] * v0[3]) + (v1[0] * v1[0] + v1[1] * v1[1]) + (v1[2] * v1[2] + v1[3] * v1[3]); }
                s += __shfl_xor(s, 16); s += __shfl_xor(s, 32);
                if (fq == 0) ssq_out[row * 16 + u.pn * 4 + wc] = s; }
    }
};

struct Frame {
    LAS unsigned char* lds;
    volatile LAS unsigned* MISC;
    gu32* ctl;
    int wave;
    int vcu, G;
    const float *x, *p, *g_mix, *w_in, *rpb, *w_bna, *w_bdil, *w_out, *g_mlp, *w_up, *w_down, *g_ple, *w_pg, *w_pp, *g_final; const int* positions;
    float* out;
    bf16 *Win_t, *Wc1_t, *Wo_t, *Wup_t, *Wdn_t, *Wc2_t;
    float* CS; float* SSQ;
    bf16 *HP, *QKV, *GATES, *MIXED, *U, *T2;
};

__device__ __forceinline__ float wave_sum(float v) {
#pragma unroll
    for (int o = 1; o < 64; o <<= 1) v += __shfl_xor(v, o);
    return v;
}
__device__ __forceinline__ void tr_item(const float* W, int N, int k0, int src_n0, bf16* WT, int ldo, int orow0, int kofs, const float* gk, LAS float* scr, int lane) {
#pragma unroll 8
    for (int i = 0; i < 32; ++i) { const int kk = 2 * i + (lane >> 5); const float gg = gk ? gk[k0 + kk] : 1.f; scr[kk * 33 + (lane & 31)] = W[(size_t)(k0 + kk) * N + src_n0 + (lane & 31)] * gg; }
    LDS_WAIT(); asm volatile("" ::: "memory");
    const int c = lane & 7;
#pragma unroll
    for (int j = 0; j < 4; ++j) { const int n = (lane >> 3) + 8 * j; const LAS float* s = scr + (8 * c) * 33 + n;
        v4u o; o.x = pk2(s[0 * 33], s[1 * 33]); o.y = pk2(s[2 * 33], s[3 * 33]); o.z = pk2(s[4 * 33], s[5 * 33]); o.w = pk2(s[6 * 33], s[7 * 33]);
        *(GAS v4u*)(WT + (size_t)(orow0 + n) * ldo + kofs + k0 + 8 * c) = o; }
    LDS_WAIT(); asm volatile("" ::: "memory");
}
__device__ __forceinline__ void tr_plain(const float* W, int K, int N, bf16* WT, int ldo, int kofs, const float* gk, LAS float* scr, int item, int lane) {
    const int nblk = N / 32, kb = item / nblk, nb = item % nblk;
    tr_item(W, N, 64 * kb, 32 * nb, WT, ldo, 32 * nb, kofs, gk, scr, lane);
}
__device__ __forceinline__ void tr_win(const float* W, bf16* WT, LAS float* scr, int item, int lane) {
    const int nblk = NIN / 32, kb = item / nblk, nb = item % nblk, n0 = 32 * nb, pn = n0 >> 8, v = n0 & 255;
    const int src = (pn >= 6 && pn < 12) ? (pn * 256 + 64 * ((v & 127) >> 5) + 32 * (v >> 7)) : n0;
    tr_item(W, NIN, 64 * kb, src, WT, DM, n0, 0, nullptr, scr, lane);
}

struct Args { const void* in[16]; float* out; unsigned char* ws; double inv_freq[32]; int ph_lo, ph_hi, li, pad; };

__device__ __forceinline__ void sincos_rev(double ang, float& c, float& s) {
    const double TWO_PI = 6.283185307179586476925286766559;
    const double n = rint(ang * (1.0 / TWO_PI)); const double r = ang - n * TWO_PI, r2 = r * r;
    double sn = 1.0 / 51090942171709440000.0;
    sn = sn * r2 - 1.0 / 121645100408832000.0;
    sn = sn * r2 + 1.0 / 355687428096000.0;
    sn = sn * r2 - 1.0 / 1307674368000.0;
    sn = sn * r2 + 1.0 / 6227020800.0;
    sn = sn * r2 - 1.0 / 39916800.0;
    sn = sn * r2 + 1.0 / 362880.0;
    sn = sn * r2 - 1.0 / 5040.0;
    sn = sn * r2 + 1.0 / 120.0;
    sn = sn * r2 - 1.0 / 6.0;
    sn = sn * r2 + 1.0; sn *= r;
    double cs = 1.0 / 2432902008176640000.0;
    cs = cs * r2 - 1.0 / 6402373705728000.0;
    cs = cs * r2 + 1.0 / 20922789888000.0;
    cs = cs * r2 - 1.0 / 87178291200.0;
    cs = cs * r2 + 1.0 / 479001600.0;
    cs = cs * r2 - 1.0 / 3628800.0;
    cs = cs * r2 + 1.0 / 40320.0;
    cs = cs * r2 - 1.0 / 720.0;
    cs = cs * r2 + 1.0 / 24.0;
    cs = cs * r2 - 0.5;
    cs = cs * r2 + 1.0;
    c = (float)cs; s = (float)sn;
}

__device__ __forceinline__ void p0_prologue(Frame& F, const Args& args) {
    LAS float* scr = (LAS float*)(F.lds + RING_OFF + F.wave * 16384);
    const int gw = F.vcu * NWAVES + F.wave, NGW = F.G * NWAVES, lane = pg8::lane_id_now(), tid = F.wave * 64 + lane;
    constexpr int I_IN = (DM / 64) * (NIN / 32), I_A = (512 / 64) * (DM / 32), I_B = (256 / 64) * (DM / 32), I_O = (DM / 64) * (DM / 32), I_UP = (DM / 64) * (DFF / 32), I_DN = (DFF / 64) * (DM / 32), I_PP = (PLE / 64) * (DM / 32), I_PG = I_O;
    constexpr int NITEMS = I_IN + I_A + I_B + I_O + I_UP + I_DN + I_PP + I_PG;
    for (int it = gw; it < NITEMS; it += NGW) {
        int r = it;
        if (r < I_IN) { tr_win(F.w_in, F.Win_t, scr, r, lane); continue; } r -= I_IN;
        if (r < I_A) { tr_plain(F.w_bna, 512, DM, F.Wc1_t, YW, 0, nullptr, scr, r, lane); continue; } r -= I_A;
        if (r < I_B) { tr_plain(F.w_bdil, 256, DM, F.Wc1_t, YW, 512, nullptr, scr, r, lane); continue; } r -= I_B;
        if (r < I_O) { tr_plain(F.w_out, DM, DM, F.Wo_t, DM, 0, nullptr, scr, r, lane); continue; } r -= I_O;
        if (r < I_UP) { tr_plain(F.w_up, DM, DFF, F.Wup_t, DM, 0, F.g_mlp, scr, r, lane); continue; } r -= I_UP;
        if (r < I_DN) { tr_plain(F.w_down, DFF, DM, F.Wdn_t, DFF, 0, nullptr, scr, r, lane); continue; } r -= I_DN;
        if (r < I_PP) { tr_plain(F.w_pp, PLE, DM, F.Wc2_t, HPW, 0, nullptr, scr, r, lane); continue; } r -= I_PP;
        tr_plain(F.w_pg, DM, DM, F.Wc2_t, HPW, PLE, F.g_ple, scr, r, lane);
    }
    for (int m = gw; m < M; m += NGW) {
        const GAS f32x4* xr = (const GAS f32x4*)(F.x + (size_t)m * DM) + lane;
        f32x4 v[4]; float s = 0.f;
#pragma unroll
        for (int j = 0; j < 4; ++j) { v[j] = xr[64 * j]; s += (v[j].x * v[j].x + v[j].y * v[j].y) + (v[j].z * v[j].z + v[j].w * v[j].w); }
        const float rstd = 1.0f / sqrtf(wave_sum(s) * (1.f / DM) + RMS_EPS);
        GAS v2u* o8 = (GAS v2u*)(F.HP + (size_t)m * HPW + PLE) + lane;
#pragma unroll
        for (int j = 0; j < 4; ++j) { const f32x4 gg = *((const GAS f32x4*)F.g_mix + lane + 64 * j);
            v2u w; w.x = pk2(v[j].x * rstd * gg.x, v[j].y * rstd * gg.y); w.y = pk2(v[j].z * rstd * gg.z, v[j].w * rstd * gg.w); o8[64 * j] = w; }
        const f32x4 pv = *((const GAS f32x4*)(F.p + (size_t)m * PLE) + lane);
        v2u w; w.x = pk2(pv.x, pv.y); w.y = pk2(pv.z, pv.w); *((GAS v2u*)(F.HP + (size_t)m * HPW) + lane) = w;
    }
    { const long gt = (long)F.vcu * (NWAVES * 64) + tid, NT = (long)F.G * NWAVES * 64;
      for (long e = gt; e < (long)M * 32; e += NT) { const int row = (int)(e >> 5), f = (int)(e & 31);
          float c, s; sincos_rev((double)F.positions[row] * args.inv_freq[f], c, s);
          *(GAS f32x2*)(F.CS + e * 2) = (f32x2){c, s}; } }
}

__device__ __forceinline__ void ld8f(const bf16* p, float (&f)[8]) { const v4u v = *(const GAS v4u*)p;
    f[0] = pg8::bf_lo(v.x); f[1] = pg8::bf_hi(v.x); f[2] = pg8::bf_lo(v.y); f[3] = pg8::bf_hi(v.y); f[4] = pg8::bf_lo(v.z); f[5] = pg8::bf_hi(v.z); f[6] = pg8::bf_lo(v.w); f[7] = pg8::bf_hi(v.w); }

__device__ __forceinline__ void attn_naive(Frame& F) {
    const long gt = (long)F.vcu * (NWAVES * 64) + F.wave * 64 + pg8::lane_id_now(), NT = (long)F.G * NWAVES * 64;
    for (long item = gt; item < (long)M * 8; item += NT) {
        const int h = (int)(item & 7), tok = (int)(item >> 3);
        const int b = tok >> 12, t = tok & 4095, r = t >> 6, c = t & 63;
        const int rs = min(max(r - 4, 0), 56), cs = min(max(c - 8, 0), 48);
        float q[64], o[64];
        { const bf16* qp = F.QKV + (size_t)tok * NQKV + h * 64;
#pragma unroll
          for (int ch = 0; ch < 8; ++ch) { float f[8]; ld8f(qp + ch * 8, f);
#pragma unroll
              for (int e = 0; e < 8; ++e) { q[ch * 8 + e] = f[e]; o[ch * 8 + e] = 0.f; } } }
        float mx = -1e30f, l = 0.f;
        for (int kk = 0; kk < 128; ++kk) {
            const int kr = rs + (kk >> 4), kc = cs + (kk & 15);
            const bf16* kp = F.QKV + (size_t)((b << 12) + kr * 64 + kc) * NQKV + 512 + h * 64;
            float s = 0.f;
#pragma unroll
            for (int ch = 0; ch < 8; ++ch) { float f[8]; ld8f(kp + ch * 8, f);
#pragma unroll
                for (int e = 0; e < 8; ++e) s += q[ch * 8 + e] * f[e]; }
            s += F.rpb[h * 465 + (kr - r + 7) * 31 + (kc - c + 15)];
            const float mn = fmaxf(mx, s), a = __expf(mx - mn), pw = __expf(s - mn);
            l = l * a + pw; mx = mn;
            const bf16* vp = kp + 512;
#pragma unroll
            for (int ch = 0; ch < 8; ++ch) { float f[8]; ld8f(vp + ch * 8, f);
#pragma unroll
                for (int e = 0; e < 8; ++e) o[ch * 8 + e] = o[ch * 8 + e] * a + pw * f[e]; }
        }
        const float il = 1.f / l; bf16* yp = F.HP + (size_t)tok * HPW + PLE + h * 64;
#pragma unroll
        for (int ch = 0; ch < 8; ++ch) { v4u w; w.x = pk2(o[ch * 8 + 0] * il, o[ch * 8 + 1] * il); w.y = pk2(o[ch * 8 + 2] * il, o[ch * 8 + 3] * il); w.z = pk2(o[ch * 8 + 4] * il, o[ch * 8 + 5] * il); w.w = pk2(o[ch * 8 + 6] * il, o[ch * 8 + 7] * il);
            *(GAS v4u*)(yp + ch * 8) = w; }
    }
    for (long item = gt; item < (long)M * 4; item += NT) {
        const int slot = (int)(item & 3), tok = (int)(item >> 2);
        const int b = tok >> 12, t = tok & 4095;
        float q[64], o[64];
#pragma unroll
        for (int e = 0; e < 64; ++e) o[e] = 0.f;
        float mx = -1e30f, l = 0.f;
        for (int g = 0; g < 3; ++g) {
            const int sh = 2 * g, L = SEQ >> sh, rho = t & ((1 << sh) - 1), i = t >> sh, rowbase = (b << 12) + rho * L, hc = (g * 4 + slot) * 64;
            { const bf16* qp = F.QKV + (size_t)(rowbase + i) * NQKV + 1536 + hc;
#pragma unroll
              for (int ch = 0; ch < 8; ++ch) { float f[8]; ld8f(qp + ch * 8, f);
#pragma unroll
                  for (int e = 0; e < 8; ++e) q[ch * 8 + e] = f[e]; } }
            const int j0 = max(0, i - 64), j1 = min(L - 1, i + 64);
            for (int j = j0; j <= j1; ++j) {
                const bf16* kp = F.QKV + (size_t)(rowbase + j) * NQKV + 2304 + hc;
                float s = 0.f;
#pragma unroll
                for (int ch = 0; ch < 8; ++ch) { float f[8]; ld8f(kp + ch * 8, f);
#pragma unroll
                    for (int e = 0; e < 8; ++e) s += q[ch * 8 + e] * f[e]; }
                const float mn = fmaxf(mx, s), a = __expf(mx - mn), pw = __expf(s - mn);
                l = l * a + pw; mx = mn;
                const bf16* vp = kp + 768;
#pragma unroll
                for (int ch = 0; ch < 8; ++ch) { float f[8]; ld8f(vp + ch * 8, f);
#pragma unroll
                    for (int e = 0; e < 8; ++e) o[ch * 8 + e] = o[ch * 8 + e] * a + pw * f[e]; }
            }
        }
        const float il = 1.f / l; bf16* yp = F.HP + (size_t)tok * HPW + PLE + 512 + slot * 64;
#pragma unroll
        for (int ch = 0; ch < 8; ++ch) { v4u w; w.x = pk2(o[ch * 8 + 0] * il, o[ch * 8 + 1] * il); w.y = pk2(o[ch * 8 + 2] * il, o[ch * 8 + 3] * il); w.z = pk2(o[ch * 8 + 4] * il, o[ch * 8 + 5] * il); w.w = pk2(o[ch * 8 + 6] * il, o[ch * 8 + 7] * il);
            *(GAS v4u*)(yp + ch * 8) = w; }
    }
}

__device__ __forceinline__ void final_norm(Frame& F) {
    const int gw = F.vcu * NWAVES + F.wave, NGW = F.G * NWAVES, lane = pg8::lane_id_now();
    const float* ssq = F.SSQ + 2 * (size_t)M * 16;
    for (int m = gw; m < M; m += NGW) {
        const float r = row_rstd(ssq, (unsigned)m);
        GAS f32x4* xr = (GAS f32x4*)(F.out + (size_t)m * DM) + lane;
#pragma unroll
        for (int j = 0; j < 4; ++j) { const f32x4 gg = *((const GAS f32x4*)F.g_final + lane + 64 * j); f32x4 v = xr[64 * j]; v = v * r * gg; xr[64 * j] = v; }
    }
}


#ifdef MK_CHECK
constexpr size_t WS_SAVE = 498 * MiB;
constexpr int CW_CHK = 8192;
constexpr int NSAMP = 512;
__device__ __forceinline__ int samp_row(int s) { return 64 * s + ((s * 37) & 63); }
__device__ __forceinline__ float bfr(float f) { return __uint_as_float(f2bf(f) << 16); }
__device__ __forceinline__ float bfv(const bf16* p) { return __uint_as_float((unsigned)(*p) << 16); }
__device__ __forceinline__ void chk_report(gu32* ctl, int phase, float got, float exp, int s, int col) {
    const float dev = fabsf(got - exp) / (0.02f + 0.02f * fabsf(exp));
    const unsigned long long v = ((unsigned long long)__float_as_uint(dev) << 32) | (unsigned)((s << 13) | col);
    atomicMax((unsigned long long*)(ctl + CW_CHK + 2 * phase), v);
}
__device__ __forceinline__ float row_rstd_direct(const float* h) { float s = 0.f; for (int k = 0; k < DM; ++k) s += h[k] * h[k]; return 1.0f / sqrtf(s * (1.f / DM) + RMS_EPS); }
__global__ void __launch_bounds__(256) chk_kernel(Args args, int phase) {
    unsigned char* ws = args.ws; gu32* ctl = (gu32*)(ws + WS_CTL);
    const float* x = (const float*)args.in[0]; const float* pin = (const float*)args.in[1]; const int* positions = (const int*)args.in[2]; const float* g_mix = (const float*)args.in[3]; const float* w_in = (const float*)args.in[4];
    const float* w_bna = (const float*)args.in[6]; const float* w_bdil = (const float*)args.in[7]; const float* w_out = (const float*)args.in[8]; const float* g_mlp = (const float*)args.in[9];
    const float* w_up = (const float*)args.in[10]; const float* w_down = (const float*)args.in[11]; const float* g_ple = (const float*)args.in[12]; const float* w_pg = (const float*)args.in[13]; const float* w_pp = (const float*)args.in[14]; const float* g_final = (const float*)args.in[15];
    const bf16* HP = (const bf16*)(ws + WS_HP); const bf16* QKV = (const bf16*)(ws + WS_QKV); const bf16* GATES = (const bf16*)(ws + WS_GATES); const bf16* MIXED = (const bf16*)(ws + WS_MIXED); const bf16* U = (const bf16*)(ws + WS_U);
    float* SAVE = (float*)(ws + WS_SAVE); const float* out = args.out;
    const long gt = (long)blockIdx.x * 256 + threadIdx.x, NT = (long)gridDim.x * 256;
    if (phase == 100) {
        for (long e = gt; e < (long)NSAMP * DM; e += NT) { const int s = (int)(e >> 10), c = (int)(e & 1023); SAVE[e] = out[(size_t)samp_row(s) * DM + c]; }
    } else if (phase == 0) {
        for (long e = gt; e < (long)NSAMP * HPW; e += NT) { const int s = (int)(e / HPW), c = (int)(e % HPW), row = samp_row(s);
            float exp; if (c < PLE) exp = pin[(size_t)row * PLE + c]; else { const float r = row_rstd_direct(x + (size_t)row * DM); exp = x[(size_t)row * DM + c - PLE] * r * g_mix[c - PLE]; }
            chk_report(ctl, 0, bfv(HP + (size_t)row * HPW + c), exp, s, c); }
    } else if (phase == 1) {
        for (long e = gt; e < (long)NSAMP * NIN; e += NT) { const int s = (int)(e / NIN), c = (int)(e % NIN), row = samp_row(s);
            const bf16* a = HP + (size_t)row * HPW + PLE;
            float v = 0.f, v2 = 0.f; const bool rot = (c >= 1536 && c < 3072); const int c2 = rot ? (c ^ 32) : c;
            for (int k = 0; k < DM; ++k) { const float av = bfv(a + k); v += av * bfr(w_in[(size_t)k * NIN + c]); if (rot) v2 += av * bfr(w_in[(size_t)k * NIN + c2]); }
            float exp, got;
            if (c >= 3840) { exp = 1.f / (1.f + expf(-v)); got = bfv(GATES + (size_t)row * NGATE + (c - 3840)); }
            else { int sh = 0; if (c >= 1536) sh = 2 * (((c - 1536) % 768) / 256);
                if (rot) { const int d = c & 63, f = d & 31; const double ang = (double)positions[row] * args.inv_freq[f]; const float cs = (float)cos(ang), sn = (float)sin(ang);
                    exp = (d < 32) ? (v * cs - v2 * sn) : (v * cs + v2 * sn); if (c < 2304) exp *= 0.125f; }
                else exp = (c < 512) ? v * 0.125f : v;
                got = bfv(QKV + (size_t)perm_row(row, sh) * NQKV + c); }
            chk_report(ctl, 1, got, exp, s, c); }
    } else if (phase == 3) {
        for (long e = gt; e < (long)NSAMP * DM; e += NT) { const int s = (int)(e >> 10), c = (int)(e & 1023), row = samp_row(s);
            const bf16* y = HP + (size_t)row * HPW + PLE; float t1 = 0.f, t2 = 0.f;
            for (int k = 0; k < 512; ++k) t1 += bfv(y + k) * bfr(w_bna[(size_t)k * DM + c]);
            for (int k = 0; k < 256; ++k) t2 += bfv(y + 512 + k) * bfr(w_bdil[(size_t)k * DM + c]);
            const float exp = bfv(GATES + (size_t)row * NGATE + c) * t1 + bfv(GATES + (size_t)row * NGATE + 1024 + c) * t2;
            chk_report(ctl, 3, bfv(MIXED + (size_t)row * DM + c), exp, s, c); }
    } else if (phase == 4) {
        for (long e = gt; e < (long)NSAMP * DM; e += NT) { const int s = (int)(e >> 10), c = (int)(e & 1023), row = samp_row(s);
            float v = 0.f; for (int k = 0; k < DM; ++k) v += bfv(MIXED + (size_t)row * DM + k) * bfr(w_out[(size_t)k * DM + c]);
            chk_report(ctl, 4, out[(size_t)row * DM + c], x[(size_t)row * DM + c] + v, s, c); }
    } else if (phase == 5) {
        for (long e = gt; e < (long)NSAMP * DFF; e += NT) { const int s = (int)(e >> 12), c = (int)(e & 4095), row = samp_row(s);
            const float r = row_rstd_direct(out + (size_t)row * DM); float v = 0.f;
            for (int k = 0; k < DM; ++k) v += bfv(HP + (size_t)row * HPW + PLE + k) * bfr(w_up[(size_t)k * DFF + c] * g_mlp[k]);
            v = fmaxf(v * r, 0.f); chk_report(ctl, 5, bfv(U + (size_t)row * DFF + c), v * v, s, c); }
    } else if (phase == 6) {
        for (long e = gt; e < (long)NSAMP * DM; e += NT) { const int s = (int)(e >> 10), c = (int)(e & 1023), row = samp_row(s);
            float v = 0.f; for (int k = 0; k < DFF; ++k) v += bfv(U + (size_t)row * DFF + k) * bfr(w_down[(size_t)k * DM + c]);
            chk_report(ctl, 6, out[(size_t)row * DM + c], SAVE[e] + v, s, c); }
    } else if (phase == 7) {
        for (long e = gt; e < (long)NSAMP * DM; e += NT) { const int s = (int)(e >> 10), c = (int)(e & 1023), row = samp_row(s);
            const float r = row_rstd_direct(SAVE + (size_t)s * DM); float v = 0.f, t = 0.f;
            for (int k = 0; k < DM; ++k) v += bfv(HP + (size_t)row * HPW + PLE + k) * bfr(w_pg[(size_t)k * DM + c] * g_ple[k]);
            for (int k = 0; k < PLE; ++k) t += bfv(HP + (size_t)row * HPW + k) * bfr(w_pp[(size_t)k * DM + c]);
            chk_report(ctl, 7, out[(size_t)row * DM + c], SAVE[e] + t / (1.f + expf(-v * r)), s, c); }
    } else if (phase == 8) {
        for (long e = gt; e < (long)NSAMP * DM; e += NT) { const int s = (int)(e >> 10), c = (int)(e & 1023), row = samp_row(s);
            const float r = row_rstd_direct(SAVE + (size_t)s * DM); chk_report(ctl, 8, out[(size_t)row * DM + c], SAVE[e] * r * g_final[c], s, c); }
    } else if (phase == 300) {
        unsigned nq = 0, ng = 0;
        for (long e = gt; e < (long)M * NQKV; e += NT) nq += (QKV[e] == 0xAAAAu) ? 1u : 0u;
        for (long e = gt; e < (long)M * NGATE; e += NT) { if (GATES[e] == 0xAAAAu) { ng += 1u; atomicOr((unsigned*)(ctl + CW_CHK + 43), (unsigned)(e & 2047)); atomicAnd((unsigned*)(ctl + CW_CHK + 44), (unsigned)(e & 2047)); atomicMax((unsigned*)(ctl + CW_CHK + 42), (unsigned)(e >> 11)); } }
        if (nq) atomicAdd((unsigned*)(ctl + CW_CHK + 39), nq); if (ng) atomicAdd((unsigned*)(ctl + CW_CHK + 40), ng);
    } else if (phase == 200) {
        if (gt == 0) { int d1 = 9, d2 = 0, E = 3;
            for (int ph = 0; ph < 9; ++ph) { const unsigned long long v = *((unsigned long long*)(ctl + CW_CHK + 2 * ph)); const float dev = __uint_as_float((unsigned)(v >> 32));
                if (dev > 1.f) { d1 = ph; const int lg = (int)floorf(log2f(dev)); d2 = lg > 9 ? 9 : lg; const unsigned loc = (unsigned)v;
#if MK_CHECK == 1
                    E = 3 + (int)((loc & 8191) >> 8);
#elif MK_CHECK == 2
                    E = 3 + (int)(((loc & 8191) & 255) >> 4);
#elif MK_CHECK == 3
                    E = 3 + (int)((loc >> 13) >> 5);
#else
                    E = 3 + (int)((loc >> 13) & 31);
#endif
                    break; } }
            float X = (float)(10 * d1 + d2); for (int i = 0; i < E; ++i) X *= 10.f;
#if MK_CHECK >= 5
            { const unsigned long long v = *((unsigned long long*)(ctl + CW_CHK + 2 * 1)); const unsigned loc = (unsigned)v; const int s_ = (int)(loc >> 13), c_ = (int)(loc & 8191), row_ = samp_row(s_);
              const float got_ = bfv(GATES + (size_t)row_ * NGATE + (c_ - 3840));
#if MK_CHECK == 5
              { const unsigned ng_ = *(unsigned*)(ctl + CW_CHK + 40), nq_ = *(unsigned*)(ctl + CW_CHK + 39); X = (float)(31 - __clz((int)(ng_ + 1u)) + 10); const int E_ = 3 + 31 - __clz((int)(nq_ + 1u)); for (int i = 0; i < E_; ++i) X *= 10.f; }
#elif MK_CHECK == 6
              X = (float)(*(unsigned*)(ctl + CW_CHK + 42)) * 1e10f;
#elif MK_CHECK == 7
              X = (float)(*(unsigned*)(ctl + CW_CHK + 43)) * 1e10f;
#else
              X = __uint_as_float((unsigned)(v >> 32)) * 1e10f;
#endif
            }
#endif
            ((float*)args.out)[0] = X; }
    }
}
#endif

__global__ void __launch_bounds__(NWAVES * 64, 2) skel_fwd(Args args) {
    extern __shared__ __attribute__((aligned(16))) unsigned char lds[];
    Frame F;
    F.lds = (LAS unsigned char*)lds;
    F.MISC = (volatile LAS unsigned*)(F.lds + MISC_OFF);
    F.wave = __builtin_amdgcn_readfirstlane((int)threadIdx.x >> 6);
    F.G = gridDim.x; { const int bx = blockIdx.x; F.vcu = (F.G % 8 == 0) ? (bx % 8) * (F.G / 8) + bx / 8 : bx; }
#define GRID_BAR(seam) do { if (N_LAUNCHES == PER_PHASE) { if (F.wave == 0 && pg8::lane_id_now() == 0) __hip_atomic_store(F.ctl + CW_TMO, 0xBADBA0u | (unsigned)(seam), RLX_AGENT); } \
    else { xcd_barrier(bar, F.wave); } } while (0)
    unsigned char* ws = args.ws;
    F.ctl = (gu32*)(ws + WS_CTL);
    F.x = (const float*)args.in[0]; F.p = (const float*)args.in[1]; F.positions = (const int*)args.in[2]; F.g_mix = (const float*)args.in[3]; F.w_in = (const float*)args.in[4];
    F.rpb = (const float*)args.in[5]; F.w_bna = (const float*)args.in[6]; F.w_bdil = (const float*)args.in[7]; F.w_out = (const float*)args.in[8]; F.g_mlp = (const float*)args.in[9];
    F.w_up = (const float*)args.in[10]; F.w_down = (const float*)args.in[11]; F.g_ple = (const float*)args.in[12]; F.w_pg = (const float*)args.in[13]; F.w_pp = (const float*)args.in[14]; F.g_final = (const float*)args.in[15];
    F.out = args.out;
    F.Win_t = (bf16*)(ws + WS_WIN); F.Wc1_t = (bf16*)(ws + WS_WC1); F.Wo_t = (bf16*)(ws + WS_WO); F.Wup_t = (bf16*)(ws + WS_WUP); F.Wdn_t = (bf16*)(ws + WS_WDN); F.Wc2_t = (bf16*)(ws + WS_WC2);
    F.CS = (float*)(ws + WS_CS); F.SSQ = (float*)(ws + WS_SSQ);
    F.HP = (bf16*)(ws + WS_HP); F.QKV = (bf16*)(ws + WS_QKV); F.GATES = (bf16*)(ws + WS_GATES); F.MIXED = (bf16*)(ws + WS_MIXED); F.U = (bf16*)(ws + WS_U); F.T2 = (bf16*)(ws + WS_T2);
    for (int u = (int)threadIdx.x; u < (LDS_BYTES - LDSCTL_OFF) / 4; u += NWAVES * 64) ((LAS unsigned*)(F.lds + LDSCTL_OFF))[u] = 0u;
    __syncthreads();
    const int bli = (N_LAUNCHES == PER_PHASE) ? 0 : args.li;
    XcdBarrier bar; bar.bar = (unsigned*)(F.ctl + CW_BAR) + bli * XCD_BAR_WORDS; bar.x = 0; bar.st = nullptr;
    if (N_LAUNCHES != PER_PHASE)
        bar = xcd_barrier_post((unsigned*)(F.ctl + CW_BAR) + bli * XCD_BAR_WORDS, F.MISC + 8);

    const int lo = args.ph_lo, hi = args.ph_hi;
#define IN(k) (lo <= (k) && (k) < hi)
#define BOTH(k) (IN(k) && IN((k) + 1))
    const int cid = (int)blockIdx.x;

    if (IN(0)) { p0_prologue(F, args); if (BOTH(0)) GRID_BAR(0); }

    if (IN(1)) {
        pg8::Gemm g{F.HP + PLE, F.Win_t, M, NIN, DM, HPW}; pg8::StaticOrder S; S.init(M, NIN, F.G, cid);
        EpiIn E{F.QKV, F.GATES, F.CS};
        pg8::gemm_phase<EpiIn, pg8::StaticOrder, PG8_ALIGN, PG8_SP2>(F.lds + RING_OFF, g, S, E, F.wave);
        if (BOTH(1)) GRID_BAR(1);
    }
    if (IN(2)) { attn_naive(F); if (BOTH(2)) GRID_BAR(2); }
    if (IN(3)) {
        pg8::Gemm g{F.HP + PLE, F.Wc1_t, M, DM, YW, HPW}; pg8::StaticOrder S; S.init(M, DM, F.G, cid);
        EpiMix E{F.GATES, F.MIXED};
        pg8::gemm_phase<EpiMix, pg8::StaticOrder, PG8_ALIGN, PG8_SP2>(F.lds + RING_OFF, g, S, E, F.wave);
        if (BOTH(3)) GRID_BAR(3);
    }
    if (IN(4)) {
        pg8::Gemm g{F.MIXED, F.Wo_t, M, DM, DM, DM}; pg8::StaticOrder S; S.init(M, DM, F.G, cid);
        EpiRes E{F.x, F.out, F.HP + PLE, F.SSQ};
        pg8::gemm_phase<EpiRes, pg8::StaticOrder, PG8_ALIGN, PG8_SP2>(F.lds + RING_OFF, g, S, E, F.wave);
        if (BOTH(4)) GRID_BAR(4);
    }
    if (IN(5)) {
        pg8::Gemm g{F.HP + PLE, F.Wup_t, M, DFF, DM, HPW}; pg8::StaticOrder S; S.init(M, DFF, F.G, cid);
        EpiUp E{F.SSQ, F.U};
        pg8::gemm_phase<EpiUp, pg8::StaticOrder, PG8_ALIGN, PG8_SP2>(F.lds + RING_OFF, g, S, E, F.wave);
        if (BOTH(5)) GRID_BAR(5);
    }
    if (IN(6)) {
        pg8::Gemm g{F.U, F.Wdn_t, M, DM, DFF, DFF}; pg8::StaticOrder S; S.init(M, DM, F.G, cid);
        EpiRes E{F.out, F.out, F.HP + PLE, F.SSQ + (size_t)M * 16};
        pg8::gemm_phase<EpiRes, pg8::StaticOrder, PG8_ALIGN, PG8_SP2>(F.lds + RING_OFF, g, S, E, F.wave);
        if (BOTH(6)) GRID_BAR(6);
    }
    if (IN(7)) {
        pg8::Gemm g{F.HP, F.Wc2_t, M, DM, HPW, HPW}; pg8::StaticOrder S; S.init(M, DM, F.G, cid);
        EpiPle E{F.T2, F.SSQ + (size_t)M * 16, F.out, F.SSQ + 2 * (size_t)M * 16};
        pg8::gemm_phase<EpiPle, pg8::StaticOrder, PG8_ALIGN, PG8_SP2>(F.lds + RING_OFF, g, S, E, F.wave);
        if (BOTH(7)) GRID_BAR(7);
    }
    if (IN(8)) { final_norm(F); }
#undef IN
#undef BOTH
}

extern "C" void kernel_launch(void* const* d_in, const int* in_sizes, int n_in, void* d_out, int out_size, void* d_ws, size_t ws_size, hipStream_t stream) {
    static int grid = 0;
    if (grid == 0) {
        if (n_in != 16 || in_sizes[0] != M * DM || out_size != M * DM || ws_size < WS_END) { fprintf(stderr, "kernel_launch: shape/workspace mismatch: n_in %d in0 %d out %d ws %zu (need %zu); nothing launched\n", n_in, n_in > 0 ? in_sizes[0] : -1, out_size, ws_size, (size_t)WS_END); grid = -1; return; }
        int dev = 0, cus = 0, per_cu = 0;
        if (hipGetDevice(&dev) != hipSuccess || hipDeviceGetAttribute(&cus, hipDeviceAttributeMultiprocessorCount, dev) != hipSuccess) { fprintf(stderr, "kernel_launch: device query failed\n"); grid = -1; return; }
        if (hipFuncSetAttribute((const void*)skel_fwd, hipFuncAttributeMaxDynamicSharedMemorySize, LDS_BYTES) != hipSuccess) { fprintf(stderr, "kernel_launch: hipFuncSetAttribute failed\n"); grid = -1; return; }
        if (hipOccupancyMaxActiveBlocksPerMultiprocessor(&per_cu, (const void*)skel_fwd, NWAVES * 64, LDS_BYTES) != hipSuccess || per_cu < 1)
            fprintf(stderr, "kernel_launch: note: occupancy query reports %d workgroups per CU\n", per_cu);
        (void)hipGetLastError();
        grid = cus;
    }
    if (grid < 0) return;
#ifdef MK_CHECK
    (void)hipMemsetAsync((char*)d_ws + WS_QKV, 0xAA, 368 * MiB, stream);
#endif
    if (hipMemsetAsync((char*)d_ws + WS_CTL, 0, CTL_ZERO_BYTES, stream) != hipSuccess) { fprintf(stderr, "kernel_launch: hipMemsetAsync failed\n"); return; }
    Args a{};
    for (int i = 0; i < 16; ++i) a.in[i] = d_in[i];
    a.out = (float*)d_out; a.ws = (unsigned char*)d_ws;
    for (int f = 0; f < 32; ++f) a.inv_freq[f] = std::pow(10000.0, -(double)f / 32.0);
    static_assert(N_LAUNCHES == 1 || N_LAUNCHES == PER_PHASE, "MK_N_LAUNCHES is 1 or 9");
    for (int li = 0; li < N_LAUNCHES; ++li) {
        a.ph_lo = (N_LAUNCHES == PER_PHASE) ? li : 0; a.ph_hi = (N_LAUNCHES == PER_PHASE) ? li + 1 : PER_PHASE; a.li = (N_LAUNCHES == PER_PHASE) ? 0 : li;
        hipLaunchKernelGGL(skel_fwd, dim3(grid), dim3(NWAVES * 64), LDS_BYTES, stream, a);
        const hipError_t le = hipPeekAtLastError();
        if (le != hipSuccess) { fprintf(stderr, "kernel_launch: launch %d failed: %s\n", li, hipGetErrorName(le)); break; }
#ifdef MK_CHECK
        if (li == 0 || li == 1 || li == 3 || li == 4 || li == 5 || li == 6 || li == 7 || li == 8) hipLaunchKernelGGL(chk_kernel, dim3(1024), dim3(256), 0, stream, a, li);
        if (li == 1) hipLaunchKernelGGL(chk_kernel, dim3(1024), dim3(256), 0, stream, a, 300);
        if (li == 5 || li == 6 || li == 7) hipLaunchKernelGGL(chk_kernel, dim3(1024), dim3(256), 0, stream, a, 100);
        if (li == 8) hipLaunchKernelGGL(chk_kernel, dim3(1), dim3(256), 0, stream, a, 200);
#endif
    }
}
```

```cpp
#include <hip/hip_runtime.h>
#include <cstdio>
#include <cstdint>
#include <cmath>

#ifndef MK_N_LAUNCHES
#define MK_N_LAUNCHES 1
#endif

namespace pg8 {
#define PG8_LAS __attribute__((address_space(3)))
typedef unsigned short bf16_t;
typedef short bf16x8 __attribute__((ext_vector_type(8)));
typedef float f32x4 __attribute__((ext_vector_type(4)));
typedef unsigned u32x4 __attribute__((ext_vector_type(4)));
constexpr int BM = 256, BK = 64, HALF = 128, HTB = HALF * BK * 2  , STAGE_BYTES = 8 * HTB, NXCD = 8, WGM = 8;

__host__ __device__ __forceinline__ int lds_byte(int r, int c) { const int st = (r >> 4) * 2 + (c >> 5), rr = r & 15, cc = c & 31, ob = rr * 64 + cc * 2; return st * 1024 + (ob ^ (((ob >> 9) & 1) << 5)); }
__host__ __device__ __forceinline__ void stage_rc(int b, int& R, int& C) { const int st = b / 1024, sb = b % 1024, swz = sb ^ (((sb >> 9) & 1) << 5); R = (st >> 1) * 16 + swz / 64; C = (st & 1) * 32 + (swz % 64) / 2; }
__host__ __device__ __forceinline__ int perm32(int rho) { const int n = rho >> 4, i = rho & 15; return 8 * (i >> 2) + 4 * n + (i & 3); }

struct Unit { int pm, pn; };
struct Gemm { const bf16_t* A; const bf16_t* Bt; int M, N, K, lda; };

struct StaticOrder {
    int nM, nN, nwg, G, c;
    __host__ __device__ void init(int M, int N, int G_, int c_) { nM = M / BM; nN = N / BM; nwg = nM * nN; G = G_; c = c_; }
    __host__ __device__ bool next(int i, Unit& u) const {
        const long L = (long)i * G + c; if (L >= nwg) return false;
        int wgid = (int)L; { const int q = nwg / NXCD, r = nwg % NXCD, xcd = wgid % NXCD, off = wgid / NXCD; wgid = (xcd < r ? xcd * (q + 1) : r * (q + 1) + (xcd - r) * q) + off; }
        const int nig = WGM * nN, gid = wgid / nig, fm = gid * WGM, gsz = (nM - fm) < WGM ? (nM - fm) : WGM;
        u.pm = fm + ((wgid % nig) % gsz); u.pn = (wgid % nig) / gsz; return true;
    }
    __device__ __forceinline__ void a_ready(const Unit&) const {}
    __device__ __forceinline__ void done(const Unit&) const {}
};

__device__ __forceinline__ int lane_id_now() { int l; asm volatile("v_mbcnt_lo_u32_b32 %0, -1, 0\n\tv_mbcnt_hi_u32_b32 %0, -1, %0" : "=v"(l)); return l; }
typedef float f32x2_t __attribute__((ext_vector_type(2))); typedef __bf16 bf16x2_t __attribute__((ext_vector_type(2)));
__device__ __forceinline__ unsigned cvt_pk_bf16(float lo, float hi) { f32x2_t v = {lo, hi}; bf16x2_t b = __builtin_convertvector(v, bf16x2_t); return __builtin_bit_cast(unsigned, b); }
__device__ __forceinline__ u32x4 pack8(const f32x4 a, const f32x4 b) { u32x4 w; w.x = cvt_pk_bf16(a[0], a[1]); w.y = cvt_pk_bf16(a[2], a[3]); w.z = cvt_pk_bf16(b[0], b[1]); w.w = cvt_pk_bf16(b[2], b[3]); return w; }
__device__ __forceinline__ float bf_lo(unsigned u) { return __uint_as_float(u << 16); }
__device__ __forceinline__ float bf_hi(unsigned u) { return __uint_as_float(u & 0xffff0000u); }
__device__ __forceinline__ void unpack8(const u32x4 w, f32x4& a, f32x4& b) { a = (f32x4){bf_lo(w.x), bf_hi(w.x), bf_lo(w.y), bf_hi(w.y)}; b = (f32x4){bf_lo(w.z), bf_hi(w.z), bf_lo(w.w), bf_hi(w.w)}; }

template <class Epi, class Sched, bool ALIGN_EPI = false, bool SP2 = false>
__device__ __forceinline__ void gemm_phase(PG8_LAS unsigned char* lds, const Gemm g, const Sched& S, const Epi& E, const int wid) {
    const int lane = lane_id_now(), tid = wid * 64 + lane, wr = wid >> 2, wc = wid & 3, fr = lane & 15, fq = lane >> 4;
    const int K = g.K, nt = K / BK, lda = g.lda;
    unsigned voffA[2], voffB[2];
#pragma unroll
    for (int i = 0; i < 2; ++i) { int R, C; stage_rc(tid * 16 + i * 8192, R, C); const int Rb = Epi::PERM ? ((R & ~31) + perm32(R & 31)) : R;
        voffA[i] = (unsigned)(R * lda + C) * 2u; voffB[i] = (unsigned)(Rb * K + C) * 2u; }
    const size_t kstep = (size_t)(BK * 2);
    const size_t hstepA = (size_t)HALF * lda * 2, hstepB = (size_t)HALF * K * 2;
    const size_t tstepA = 2 * hstepA, tstepB = 2 * hstepB;
    const unsigned ldsw = (unsigned)wid * 1024u;
    const int aoff = lds_byte(wr * 64 + fr, fq * 8), boff = lds_byte(wc * 32 + fr, fq * 8);
#define PG8_SA(b, h) (((b) * 2 + (h)) * HTB)
#define PG8_SB(b, h) ((4 + (b) * 2 + (h)) * HTB)
#define PG8_STAGE(bufoff, gbase, voff) do { _Pragma("unroll") for (int _i = 0; _i < 2; ++_i) \
        __builtin_amdgcn_global_load_lds((const unsigned*)((const char*)(gbase) + (voff)[_i]), (PG8_LAS unsigned*)(lds + (bufoff) + ldsw + _i * 8192), 16, 0, 0); } while (0)
#define PG8_LDA(dst, b, h) do { _Pragma("unroll") for (int m = 0; m < 4; ++m) _Pragma("unroll") for (int k = 0; k < 2; ++k) dst[m][k] = *(const PG8_LAS bf16x8*)(lds + PG8_SA(b, h) + aoff + m * 2048 + k * 1024); } while (0)
#define PG8_LDB(dst, b, h) do { _Pragma("unroll") for (int n = 0; n < 2; ++n) _Pragma("unroll") for (int k = 0; k < 2; ++k) dst[n][k] = *(const PG8_LAS bf16x8*)(lds + PG8_SB(b, h) + boff + n * 2048 + k * 1024); } while (0)
#define PG8_MMA(ai, bj, At, Bt) do { __builtin_amdgcn_s_setprio(1); _Pragma("unroll") for (int m = 0; m < 4; ++m) _Pragma("unroll") for (int n = 0; n < 2; ++n) _Pragma("unroll") for (int k = 0; k < 2; ++k) \
        acc[ai][bj][m][n] = __builtin_amdgcn_mfma_f32_16x16x32_bf16(Bt[n][k], At[m][k], acc[ai][bj][m][n], 0, 0, 0); __builtin_amdgcn_s_setprio(0); } while (0)
#define PG8_WAIT_V(n) asm volatile("s_waitcnt vmcnt(" #n ")" ::: "memory")
#define PG8_WAIT_L(n) asm volatile("s_waitcnt lgkmcnt(" #n ")" ::: "memory")
#define PG8_BAR __builtin_amdgcn_s_barrier()
#define PG8_SCHED __builtin_amdgcn_sched_barrier(0)
    Unit cur, nxt; int ui = 0;
    if (!S.next(0, cur)) return;
    f32x4 acc[2][2][4][2];
#pragma unroll
    for (int a = 0; a < 2; ++a)
#pragma unroll
        for (int b = 0; b < 2; ++b)
#pragma unroll
            for (int m = 0; m < 4; ++m)
#pragma unroll
                for (int n = 0; n < 2; ++n) acc[a][b][m][n] = (f32x4){0.f, 0.f, 0.f, 0.f};
    bf16x8 At[4][2], B0[2][2], B1[2][2];
    const char* cA = (const char*)g.A + (size_t)cur.pm * tstepA; const char* cB = (const char*)g.Bt + (size_t)cur.pn * tstepB;
    S.a_ready(cur);
    if constexpr (SP2) {
        PG8_STAGE(PG8_SB(0, 0), cB, voffB); PG8_STAGE(PG8_SB(0, 1), cB + hstepB, voffB); PG8_STAGE(PG8_SA(0, 0), cA, voffA); PG8_STAGE(PG8_SA(0, 1), cA + hstepA, voffA);
        if (wr == 1) PG8_BAR;
        PG8_WAIT_V(2); PG8_BAR;
        PG8_STAGE(PG8_SB(1, 0), cB + kstep, voffB); PG8_STAGE(PG8_SA(1, 0), cA + kstep, voffA); PG8_STAGE(PG8_SB(1, 1), cB + hstepB + kstep, voffB);
        PG8_WAIT_V(6); PG8_BAR;
    } else {
        PG8_STAGE(PG8_SB(0, 0), cB, voffB); PG8_STAGE(PG8_SA(0, 0), cA, voffA); PG8_STAGE(PG8_SB(0, 1), cB + hstepB, voffB); PG8_STAGE(PG8_SA(0, 1), cA + hstepA, voffA);
        if (wr == 1) PG8_BAR;
        PG8_WAIT_V(4); PG8_BAR;
        PG8_STAGE(PG8_SB(1, 0), cB + kstep, voffB); PG8_STAGE(PG8_SA(1, 0), cA + kstep, voffA); PG8_STAGE(PG8_SB(1, 1), cB + hstepB + kstep, voffB);
        PG8_WAIT_V(6); PG8_BAR;
    }
    for (;;) {
        const bool has_next = S.next(ui + 1, nxt);
        const char* nA = has_next ? (const char*)g.A + (size_t)nxt.pm * tstepA : cA; const char* nB = has_next ? (const char*)g.Bt + (size_t)nxt.pn * tstepB : cB;
        for (int t = 0; t < nt; t += 2) {
            if constexpr (Epi::HAS_MID) { if (t == Epi::MID_T) E.mid(acc, cur, wr, wc, fr, fq); }
            const bool last = (t == nt - 2);
            const char* a1 = cA + (size_t)(t + 1) * kstep;
            const char* a2 = last ? nA : cA + (size_t)(t + 2) * kstep; const char* b2 = last ? nB : cB + (size_t)(t + 2) * kstep;
            const char* a3 = a2 + kstep; const char* b3 = b2 + kstep;
            if (last && has_next) S.a_ready(nxt);
            if constexpr (SP2) {
            PG8_LDB(B0, 0, 0); PG8_LDB(B1, 0, 1); PG8_SCHED; PG8_LDA(At, 0, 0); PG8_STAGE(PG8_SA(1, 1), a1 + hstepA, voffA);
            PG8_WAIT_V(8); PG8_WAIT_L(0); PG8_BAR; PG8_MMA(0, 0, At, B0); PG8_MMA(0, 1, At, B1); PG8_BAR; PG8_SCHED;
            PG8_LDA(At, 0, 1); PG8_STAGE(PG8_SB(0, 0), b2, voffB); PG8_STAGE(PG8_SB(0, 1), b2 + hstepB, voffB); PG8_STAGE(PG8_SA(0, 0), a2, voffA);
            PG8_WAIT_V(8); PG8_WAIT_L(0); PG8_BAR; PG8_MMA(1, 0, At, B0); PG8_MMA(1, 1, At, B1); PG8_BAR; PG8_SCHED;
            PG8_LDB(B0, 1, 0); PG8_LDB(B1, 1, 1); PG8_SCHED; PG8_LDA(At, 1, 0); PG8_STAGE(PG8_SA(0, 1), a2 + hstepA, voffA);
            PG8_WAIT_V(8); PG8_WAIT_L(0); PG8_BAR; PG8_MMA(0, 0, At, B0); PG8_MMA(0, 1, At, B1); PG8_BAR; PG8_SCHED;
            PG8_LDA(At, 1, 1); PG8_STAGE(PG8_SB(1, 0), b3, voffB); PG8_STAGE(PG8_SB(1, 1), b3 + hstepB, voffB); PG8_STAGE(PG8_SA(1, 0), a3, voffA);
            PG8_WAIT_V(8); PG8_WAIT_L(0); PG8_BAR; PG8_MMA(1, 0, At, B0); PG8_MMA(1, 1, At, B1); PG8_BAR; PG8_SCHED;
            } else {
            PG8_LDB(B0, 0, 0); PG8_SCHED; PG8_LDA(At, 0, 0); PG8_STAGE(PG8_SA(1, 1), a1 + hstepA, voffA);
            PG8_WAIT_L(8); PG8_BAR; PG8_WAIT_L(0); PG8_MMA(0, 0, At, B0); PG8_BAR; PG8_SCHED;
            PG8_LDB(B1, 0, 1); PG8_STAGE(PG8_SB(0, 0), b2, voffB);
            PG8_BAR; PG8_WAIT_L(0); PG8_MMA(0, 1, At, B1); PG8_BAR;
            PG8_LDA(At, 0, 1); PG8_STAGE(PG8_SA(0, 0), a2, voffA);
            PG8_BAR; PG8_WAIT_L(0); PG8_MMA(1, 0, At, B0); PG8_BAR; PG8_SCHED;
            PG8_STAGE(PG8_SB(0, 1), b2 + hstepB, voffB);
            PG8_WAIT_V(6); PG8_BAR; PG8_MMA(1, 1, At, B1); PG8_BAR;
            PG8_LDB(B0, 1, 0); PG8_SCHED; PG8_LDA(At, 1, 0); PG8_STAGE(PG8_SA(0, 1), a2 + hstepA, voffA);
            PG8_WAIT_L(8); PG8_BAR; PG8_WAIT_L(0); PG8_MMA(0, 0, At, B0); PG8_BAR; PG8_SCHED;
            PG8_LDB(B1, 1, 1); PG8_STAGE(PG8_SB(1, 0), b3, voffB);
            PG8_BAR; PG8_WAIT_L(0); PG8_MMA(0, 1, At, B1); PG8_BAR;
            PG8_LDA(At, 1, 1); PG8_STAGE(PG8_SA(1, 0), a3, voffA);
            PG8_BAR; PG8_WAIT_L(0); PG8_MMA(1, 0, At, B0); PG8_BAR; PG8_SCHED;
            PG8_STAGE(PG8_SB(1, 1), b3 + hstepB, voffB);
            PG8_WAIT_V(6); PG8_BAR; PG8_MMA(1, 1, At, B1); PG8_BAR;
            }
        }
        if constexpr (ALIGN_EPI) { if (wr == 0) PG8_BAR; }
        E(acc, cur, wr, wc, fr, fq); S.done(cur);
        if (!has_next) break;
#pragma unroll
        for (int a = 0; a < 2; ++a)
#pragma unroll
            for (int b = 0; b < 2; ++b)
#pragma unroll
                for (int m = 0; m < 4; ++m)
#pragma unroll
                    for (int n = 0; n < 2; ++n) acc[a][b][m][n] = (f32x4){0.f, 0.f, 0.f, 0.f};
        cur = nxt; cA = nA; cB = nB; ++ui;
        if constexpr (ALIGN_EPI) { if (wr == 1) PG8_BAR; }
    }
    PG8_WAIT_V(0);
    if constexpr (!ALIGN_EPI) { if (wr == 0) PG8_BAR; }
    PG8_BAR;
#undef PG8_SA
#undef PG8_SB
#undef PG8_STAGE
#undef PG8_LDA
#undef PG8_LDB
#undef PG8_MMA
#undef PG8_WAIT_V
#undef PG8_WAIT_L
#undef PG8_BAR
#undef PG8_SCHED
}
}

#ifndef PG8_SP2
#define PG8_SP2 true
#endif
#ifndef PG8_ALIGN
#define PG8_ALIGN true
#endif

constexpr int NWAVES = 8;
constexpr int N_LAUNCHES = MK_N_LAUNCHES;
constexpr int PER_PHASE = 9;
constexpr int BATCH = 8, SEQ = 4096, DM = 1024, M = BATCH * SEQ;
constexpr int NQKV = 3840, NGATE = 2048, NIN = 5888, DFF = 4096, PLE = 256, HPW = 1280, YW = 768;
constexpr float RMS_EPS = 1e-6f;

constexpr size_t MiB = 1u << 20;
constexpr size_t WS_CTL = 0, CTL_ZERO_BYTES = 1 * MiB;
constexpr size_t WS_WIN = 1 * MiB, WS_WC1 = 13 * MiB, WS_WO = 15 * MiB, WS_WUP = 17 * MiB, WS_WDN = 25 * MiB, WS_WC2 = 33 * MiB;
constexpr size_t WS_CS = 36 * MiB;
constexpr size_t WS_SSQ = 44 * MiB;
constexpr size_t WS_HP = 50 * MiB;
constexpr size_t WS_QKV = 130 * MiB;
constexpr size_t WS_GATES = 370 * MiB;
constexpr size_t WS_MIXED = 130 * MiB;
constexpr size_t WS_U = 130 * MiB;
constexpr size_t WS_T2 = 130 * MiB;
constexpr size_t WS_END = 498 * MiB;
constexpr int CW_TMO = 0, CW_CODE = 1;
constexpr int CW_BAR = 4096;

constexpr int RING_OFF = 0, RING_BYTES = 131072;
constexpr int LDSCTL_OFF = RING_BYTES, MISC_OFF = LDSCTL_OFF + 320;
constexpr int LDS_BYTES = 147456;

#define GAS __attribute__((address_space(1)))
#define LAS __attribute__((address_space(3)))
typedef unsigned short bf16;
typedef unsigned v4u __attribute__((ext_vector_type(4)));
typedef unsigned v2u __attribute__((ext_vector_type(2)));
typedef float f32x4 __attribute__((ext_vector_type(4)));
typedef float f32x2 __attribute__((ext_vector_type(2)));
typedef GAS unsigned gu32;
#define RLX_AGENT __ATOMIC_RELAXED, __HIP_MEMORY_SCOPE_AGENT
#define LDS_WAIT() asm volatile("s_waitcnt lgkmcnt(0)" ::: "memory")
#define VM_WAIT() asm volatile("s_waitcnt vmcnt(0)" ::: "memory")
__device__ __forceinline__ unsigned f2bf(float f) { unsigned u = __builtin_bit_cast(unsigned, f); return (u + 0x7fffu + ((u >> 16) & 1u)) >> 16; }
__device__ __forceinline__ unsigned pk2(float lo, float hi) { return f2bf(lo) | (f2bf(hi) << 16); }
__device__ __forceinline__ float sigmoidf_(float x) { return __builtin_amdgcn_rcpf(1.f + __expf(-x)); }

#define XB_TMO      128
#define XB_XCNT(j)  (256  + 64 * (j))
#define XB_XSUB(j)  (1280 + 64 * (j))
#define XB_XGEN(j)  (2304 + 64 * (j))
#define XB_TOP      3328
#define XB_TOPGEN   3392
#define XCD_BAR_WORDS 3456
#define XB_SPIN_CAP (1u << 18)

__device__ __forceinline__ unsigned xb_ld(unsigned* p)              { return __hip_atomic_load(p, __ATOMIC_RELAXED, __HIP_MEMORY_SCOPE_AGENT); }
__device__ __forceinline__ unsigned xb_add(unsigned* p, unsigned v) { return __hip_atomic_fetch_add(p, v, __ATOMIC_RELAXED, __HIP_MEMORY_SCOPE_AGENT); }
__device__ __forceinline__ unsigned xb_xcc_id() { return (unsigned)__builtin_amdgcn_s_getreg((3 << 11) | 20) & 0xFu; }
#define XB_SPIN(cond, bar) do { unsigned _sp = 0; while (cond) { __builtin_amdgcn_s_sleep(1); \
    if ((++_sp & 255u) == 0u) { if (xb_ld(&(bar)[XB_TMO])) break; if (_sp > XB_SPIN_CAP) { atomicAdd(&(bar)[XB_TMO], 1u); break; } } } } while (0)

struct XcdBarrier { unsigned* bar; unsigned x; volatile LAS unsigned* st; };

__device__ __forceinline__ XcdBarrier xcd_barrier_post(unsigned* bar, volatile LAS unsigned* st) {
    XcdBarrier b; b.bar = bar; b.x = xb_xcc_id(); b.st = st;
    if (threadIdx.x == 0) (void)xb_add(&bar[XB_XCNT(b.x)], 1u);
    return b;
}
__device__ __forceinline__ void xcd_barrier_complete(unsigned* bar, unsigned x, unsigned& nloc, unsigned& nx) {
    const unsigned G = gridDim.x * gridDim.y * gridDim.z;
    unsigned sum, cnt, mine, sp = 0u;
    for (;;) {
        sum = 0u; cnt = 0u; mine = 0u;
#pragma unroll
        for (unsigned j = 0; j < 16; ++j) { const unsigned c = xb_ld(&bar[XB_XCNT(j)]); sum += c; cnt += (c > 0u) ? 1u : 0u; mine = (j == x) ? c : mine; }
        if (sum == G) break;
        __builtin_amdgcn_s_sleep(1);
        if ((++sp & 255u) == 0u) { if (xb_ld(&bar[XB_TMO])) break; if (sp > XB_SPIN_CAP) { atomicAdd(&bar[XB_TMO], 1u); break; } }
    }
    nloc = mine > 0u ? mine : 1u; nx = cnt > 0u ? cnt : 1u;
}
__device__ __forceinline__ void xcd_barrier(const XcdBarrier& b, const int wave) {
    asm volatile("s_waitcnt vmcnt(0)" ::: "memory");
    __syncthreads();
    if (wave == 0 && pg8::lane_id_now() == 0) {
        unsigned* bar = b.bar;
        __builtin_amdgcn_s_waitcnt(0);
        unsigned nloc = b.st[0], nx = b.st[1];
        if (nloc == 0u) { xcd_barrier_complete(bar, b.x, nloc, nx); b.st[0] = nloc; b.st[1] = nx; }
        const unsigned old = xb_add(&bar[XB_XSUB(b.x)], 1u);
        const unsigned gen = old / nloc;
        if (old + 1u == (gen + 1u) * nloc) {
            __builtin_amdgcn_fence(__ATOMIC_RELEASE, "agent");
            asm volatile("s_waitcnt vmcnt(0)" ::: "memory");
            const unsigned og = xb_add(&bar[XB_TOP], 1u);
            const unsigned tg = og / nx;
            if (og + 1u == (tg + 1u) * nx) xb_add(&bar[XB_TOPGEN], 1u);
            else XB_SPIN(xb_ld(&bar[XB_TOPGEN]) == tg, bar);
            __builtin_amdgcn_fence(__ATOMIC_ACQUIRE, "agent");
            xb_add(&bar[XB_XGEN(b.x)], 1u);
            asm volatile("s_waitcnt vmcnt(0)" ::: "memory");
        } else {
            XB_SPIN(xb_ld(&bar[XB_XGEN(b.x)]) == gen, bar);
            __builtin_amdgcn_fence(__ATOMIC_ACQUIRE, "agent");
            asm volatile("s_waitcnt vmcnt(0)" ::: "memory");
        }
    }
    __syncthreads();
}

using pg8::f32x4; using pg8::u32x4; using pg8::Unit; using pg8::pack8; using pg8::unpack8;
typedef f32x4 acc_t[2][2][4][2];

__device__ __forceinline__ int perm_row(int row, int sh) {
    const int t = row & (SEQ - 1);
    return (row & ~(SEQ - 1)) | ((t & ((1 << sh) - 1)) << (12 - sh)) | (t >> sh);
}

#define EPI_ROW0() unsigned rbase = (unsigned)(u.pm * 256 + wr * 64 + fr); asm volatile("" : "+v"(rbase))

struct EpiIn {
    static constexpr bool PERM = true, HAS_MID = false; static constexpr int MID_T = -1;
    bf16* QKV; bf16* GATES; const float* CS;
    __device__ __forceinline__ void mid(acc_t&, const Unit&, int, int, int, int) const {}
    __device__ __forceinline__ void operator()(const acc_t& acc, const Unit& u, int wr, int wc, int fr, int fq) const {
        const int pn = u.pn; EPI_ROW0();
        if (pn >= 15) {
            const unsigned col0 = (unsigned)((pn - 15) * 256 + wc * 32 + 8 * fq);
#pragma unroll
            for (int ai = 0; ai < 2; ++ai)
#pragma unroll
                for (int m = 0; m < 4; ++m) { const unsigned ro = (rbase + ai * 128 + m * 16) * NGATE + col0;
#pragma unroll
                    for (int bj = 0; bj < 2; ++bj) { f32x4 v0 = acc[ai][bj][m][0], v1 = acc[ai][bj][m][1];
#pragma unroll
                        for (int j = 0; j < 4; ++j) { v0[j] = sigmoidf_(v0[j]); v1[j] = sigmoidf_(v1[j]); }
                        *(u32x4*)(GATES + (ro + bj * 128)) = pack8(v0, v1); } }
        } else if (pn >= 6 && pn < 12) {
            const int g = (pn - 6) % 3, sh = 2 * g; const float sc = pn < 9 ? 0.125f : 1.f;
            const unsigned col0 = (unsigned)(pn * 256 + wc * 64 + 8 * fq);
#pragma unroll
            for (int ai = 0; ai < 2; ++ai)
#pragma unroll
                for (int m = 0; m < 4; ++m) { const unsigned row = rbase + ai * 128 + m * 16; const unsigned ro = (unsigned)perm_row((int)row, sh) * NQKV + col0;
                    const f32x4* cs = (const f32x4*)(CS + (row * 64u + 16u * fq));
                    const f32x4 c01 = cs[0], c23 = cs[1], c45 = cs[2], c67 = cs[3];
                    const float cc[8] = {c01[0], c01[2], c23[0], c23[2], c45[0], c45[2], c67[0], c67[2]};
                    const float ss[8] = {c01[1], c01[3], c23[1], c23[3], c45[1], c45[3], c67[1], c67[3]};
                    f32x4 o1[2], o2[2];
#pragma unroll
                    for (int n = 0; n < 2; ++n)
#pragma unroll
                        for (int j = 0; j < 4; ++j) { const float x1 = acc[ai][0][m][n][j], x2 = acc[ai][1][m][n][j], c = cc[4 * n + j], sn = ss[4 * n + j];
                            o1[n][j] = (x1 * c - x2 * sn) * sc; o2[n][j] = (x2 * c + x1 * sn) * sc; }
                    *(u32x4*)(QKV + ro) = pack8(o1[0], o1[1]); *(u32x4*)(QKV + (ro + 32)) = pack8(o2[0], o2[1]); }
        } else {
            const float sc = pn < 2 ? 0.125f : 1.f; const int sh = pn >= 12 ? 2 * (pn - 12) : 0;
            const unsigned col0 = (unsigned)(pn * 256 + wc * 32 + 8 * fq);
#pragma unroll
            for (int ai = 0; ai < 2; ++ai)
#pragma unroll
                for (int m = 0; m < 4; ++m) { const unsigned row = rbase + ai * 128 + m * 16; const unsigned ro = (unsigned)perm_row((int)row, sh) * NQKV + col0;
#pragma unroll
                    for (int bj = 0; bj < 2; ++bj) *(u32x4*)(QKV + (ro + bj * 128)) = pack8(acc[ai][bj][m][0] * sc, acc[ai][bj][m][1] * sc); }
        }
    }
};

struct EpiMix {
    static constexpr bool PERM = true, HAS_MID = true; static constexpr int MID_T = 8;
    const bf16* GATES; bf16* MIXED;
    __device__ __forceinline__ void mid(acc_t& acc, const Unit& u, int wr, int wc, int fr, int fq) const {
        EPI_ROW0(); const unsigned col0 = (unsigned)(u.pn * 256 + wc * 32 + 8 * fq);
#pragma unroll
        for (int ai = 0; ai < 2; ++ai)
#pragma unroll
            for (int m = 0; m < 4; ++m) { const unsigned ro = (rbase + ai * 128 + m * 16) * NGATE + col0;
#pragma unroll
                for (int bj = 0; bj < 2; ++bj) { f32x4 a0, a1, b0, b1; unpack8(*(const u32x4*)(GATES + (ro + bj * 128)), a0, a1); unpack8(*(const u32x4*)(GATES + (ro + bj * 128 + 1024)), b0, b1);
#pragma unroll
                    for (int j = 0; j < 4; ++j) { acc[ai][bj][m][0][j] *= a0[j] * __builtin_amdgcn_rcpf(fmaxf(b0[j], 1e-30f)); acc[ai][bj][m][1][j] *= a1[j] * __builtin_amdgcn_rcpf(fmaxf(b1[j], 1e-30f)); } } }
    }
    __device__ __forceinline__ void operator()(const acc_t& acc, const Unit& u, int wr, int wc, int fr, int fq) const {
        EPI_ROW0(); const unsigned col0 = (unsigned)(u.pn * 256 + wc * 32 + 8 * fq);
#pragma unroll
        for (int ai = 0; ai < 2; ++ai)
#pragma unroll
            for (int m = 0; m < 4; ++m) { const unsigned row = rbase + ai * 128 + m * 16; const unsigned go = row * NGATE + 1024 + col0, oo = row * DM + col0;
#pragma unroll
                for (int bj = 0; bj < 2; ++bj) { f32x4 b0, b1; unpack8(*(const u32x4*)(GATES + (go + bj * 128)), b0, b1);
                    *(u32x4*)(MIXED + (oo + bj * 128)) = pack8(acc[ai][bj][m][0] * b0, acc[ai][bj][m][1] * b1); } }
    }
};

struct EpiRes {
    static constexpr bool PERM = true, HAS_MID = false; static constexpr int MID_T = -1;
    const float* base; float* out; bf16* HB; float* ssq;
    __device__ __forceinline__ void mid(acc_t&, const Unit&, int, int, int, int) const {}
    __device__ __forceinline__ void operator()(const acc_t& acc, const Unit& u, int wr, int wc, int fr, int fq) const {
        EPI_ROW0(); const unsigned col0 = (unsigned)(u.pn * 256 + wc * 32 + 8 * fq);
#pragma unroll
        for (int ai = 0; ai < 2; ++ai)
#pragma unroll
            for (int m = 0; m < 4; ++m) { const unsigned row = rbase + ai * 128 + m * 16; float s = 0.f;
#pragma unroll
                for (int bj = 0; bj < 2; ++bj) { const unsigned off = row * DM + col0 + bj * 128;
                    const f32x4 v0 = *(const f32x4*)(base + off) + acc[ai][bj][m][0], v1 = *(const f32x4*)(base + (off + 4)) + acc[ai][bj][m][1];
                    *(f32x4*)(out + off) = v0; *(f32x4*)(out + (off + 4)) = v1;
                    s += (v0[0] * v0[0] + v0[1] * v0[1]) + (v0[2] * v0[2] + v0[3] * v0[3]) + (v1[0] * v1[0] + v1[1] * v1[1]) + (v1[2] * v1[2] + v1[3] * v1[3]);
                    *(u32x4*)(HB + (row * HPW + col0 + bj * 128)) = pack8(v0, v1); }
                s += __shfl_xor(s, 16); s += __shfl_xor(s, 32);
                if (fq == 0) ssq[row * 16 + u.pn * 4 + wc] = s; }
    }
};

__device__ __forceinline__ float row_rstd(const float* ssq, unsigned row) {
    const f32x4* p = (const f32x4*)(ssq + row * 16u); const f32x4 a = p[0], b = p[1], c = p[2], d = p[3];
    const float s = ((a[0] + a[1]) + (a[2] + a[3])) + ((b[0] + b[1]) + (b[2] + b[3])) + ((c[0] + c[1]) + (c[2] + c[3])) + ((d[0] + d[1]) + (d[2] + d[3]));
    return 1.0f / sqrtf(s * (1.0f / DM) + RMS_EPS);
}

struct EpiUp {
    static constexpr bool PERM = true, HAS_MID = false; static constexpr int MID_T = -1;
    const float* ssq; bf16* U;
    __device__ __forceinline__ void mid(acc_t&, const Unit&, int, int, int, int) const {}
    __device__ __forceinline__ void operator()(const acc_t& acc, const Unit& u, int wr, int wc, int fr, int fq) const {
        EPI_ROW0(); const unsigned col0 = (unsigned)(u.pn * 256 + wc * 32 + 8 * fq);
#pragma unroll
        for (int ai = 0; ai < 2; ++ai)
#pragma unroll
            for (int m = 0; m < 4; ++m) { const unsigned row = rbase + ai * 128 + m * 16; const float r = row_rstd(ssq, row); const unsigned oo = row * DFF + col0;
#pragma unroll
                for (int bj = 0; bj < 2; ++bj) { f32x4 v0 = acc[ai][bj][m][0] * r, v1 = acc[ai][bj][m][1] * r;
#pragma unroll
                    for (int j = 0; j < 4; ++j) { const float a = fmaxf(v0[j], 0.f), b = fmaxf(v1[j], 0.f); v0[j] = a * a; v1[j] = b * b; }
                    *(u32x4*)(U + (oo + bj * 128)) = pack8(v0, v1); } }
    }
};

struct EpiPle {
    static constexpr bool PERM = true, HAS_MID = true; static constexpr int MID_T = 4;
    bf16* T2; const float* ssq_in; float* out; float* ssq_out;
    __device__ __forceinline__ void mid(acc_t& acc, const Unit& u, int wr, int wc, int fr, int fq) const {
        EPI_ROW0(); const unsigned col0 = (unsigned)(u.pn * 256 + wc * 32 + 8 * fq);
#pragma unroll
        for (int ai = 0; ai < 2; ++ai)
#pragma unroll
            for (int m = 0; m < 4; ++m) { const unsigned to = (rbase + ai * 128 + m * 16) * DM + col0;
#pragma unroll
                for (int bj = 0; bj < 2; ++bj) { *(u32x4*)(T2 + (to + bj * 128)) = pack8(acc[ai][bj][m][0], acc[ai][bj][m][1]);
                    acc[ai][bj][m][0] = (f32x4){0.f, 0.f, 0.f, 0.f}; acc[ai][bj][m][1] = (f32x4){0.f, 0.f, 0.f, 0.f}; } }
    }
    __device__ __forceinline__ void operator()(const acc_t& acc, const Unit& u, int wr, int wc, int fr, int fq) const {
        EPI_ROW0(); const unsigned col0 = (unsigned)(u.pn * 256 + wc * 32 + 8 * fq);
#pragma unroll
        for (int ai = 0; ai < 2; ++ai)
#pragma unroll
            for (int m = 0; m < 4; ++m) { const unsigned row = rbase + ai * 128 + m * 16; const float r = row_rstd(ssq_in, row); float s = 0.f;
#pragma unroll
                for (int bj = 0; bj < 2; ++bj) { const unsigned off = row * DM + col0 + bj * 128;
                    f32x4 t0, t1; unpack8(*(const u32x4*)(T2 + off), t0, t1);
                    f32x4 v0 = *(const f32x4*)(out + off), v1 = *(const f32x4*)(out + (off + 4));
#pragma unroll
                    for (int j = 0; j < 4; ++j) { v0[j] += sigmoidf_(acc[ai][bj][m][0][j] * r) * t0[j]; v1[j] += sigmoidf_(acc[ai][bj][m][1][j] * r) * t1[j]; }
                    *(f32x4*)(out + off) = v0; *(f32x4*)(out + (off + 4)) = v1;
                    s += (v0[0] * v0[0] + v0[1] * v0[1]) + (v0[2] * v0[2] + v0[3] * v0[3]) + (v1[0] * v1[0] + v1[1] * v1[1]) + (v1[2] * v1[2] + v1[3] * v1[3]); }
                s += __shfl_xor(s, 16); s += __shfl_xor(s, 32);
                if (fq == 0) ssq_out[row * 16 + u.pn * 4 + wc] = s; }
    }
};

struct Frame {
    LAS unsigned char* lds;
    volatile LAS unsigned* MISC;
    gu32* ctl;
    int wave;
    int vcu, G;
    const float *x, *p, *g_mix, *w_in, *rpb, *w_bna, *w_bdil, *w_out, *g_mlp, *w_up, *w_down, *g_ple, *w_pg, *w_pp, *g_final; const int* positions;
    float* out;
    bf16 *Win_t, *Wc1_t, *Wo_t, *Wup_t, *Wdn_t, *Wc2_t;
    float* CS; float* SSQ;
    bf16 *HP, *QKV, *GATES, *MIXED, *U, *T2;
};

__device__ __forceinline__ float wave_sum(float v) {
#pragma unroll
    for (int o = 1; o < 64; o <<= 1) v += __shfl_xor(v, o);
    return v;
}
__device__ __forceinline__ void tr_item(const float* W, int N, int k0, int src_n0, bf16* WT, int ldo, int orow0, int kofs, const float* gk, LAS float* scr, int lane) {
#pragma unroll 8
    for (int i = 0; i < 32; ++i) { const int kk = 2 * i + (lane >> 5); const float gg = gk ? gk[k0 + kk] : 1.f; scr[kk * 33 + (lane & 31)] = W[(size_t)(k0 + kk) * N + src_n0 + (lane & 31)] * gg; }
    LDS_WAIT(); asm volatile("" ::: "memory");
    const int c = lane & 7;
#pragma unroll
    for (int j = 0; j < 4; ++j) { const int n = (lane >> 3) + 8 * j; const LAS float* s = scr + (8 * c) * 33 + n;
        v4u o; o.x = pk2(s[0 * 33], s[1 * 33]); o.y = pk2(s[2 * 33], s[3 * 33]); o.z = pk2(s[4 * 33], s[5 * 33]); o.w = pk2(s[6 * 33], s[7 * 33]);
        *(GAS v4u*)(WT + (size_t)(orow0 + n) * ldo + kofs + k0 + 8 * c) = o; }
    LDS_WAIT(); asm volatile("" ::: "memory");
}
__device__ __forceinline__ void tr_plain(const float* W, int K, int N, bf16* WT, int ldo, int kofs, const float* gk, LAS float* scr, int item, int lane) {
    const int nblk = N / 32, kb = item / nblk, nb = item % nblk;
    tr_item(W, N, 64 * kb, 32 * nb, WT, ldo, 32 * nb, kofs, gk, scr, lane);
}
__device__ __forceinline__ void tr_win(const float* W, bf16* WT, LAS float* scr, int item, int lane) {
    const int nblk = NIN / 32, kb = item / nblk, nb = item % nblk, n0 = 32 * nb, pn = n0 >> 8, v = n0 & 255;
    const int src = (pn >= 6 && pn < 12) ? (pn * 256 + 64 * ((v & 127) >> 5) + 32 * (v >> 7)) : n0;
    tr_item(W, NIN, 64 * kb, src, WT, DM, n0, 0, nullptr, scr, lane);
}

struct Args { const void* in[16]; float* out; unsigned char* ws; double inv_freq[32]; int ph_lo, ph_hi, li, pad; };

__device__ __forceinline__ void sincos_rev(double ang, float& c, float& s) {
    const double TWO_PI = 6.283185307179586476925286766559;
    const double n = rint(ang * (1.0 / TWO_PI)); const double r = ang - n * TWO_PI, r2 = r * r;
    double sn = 1.0 / 51090942171709440000.0;
    sn = sn * r2 - 1.0 / 121645100408832000.0;
    sn = sn * r2 + 1.0 / 355687428096000.0;
    sn = sn * r2 - 1.0 / 1307674368000.0;
    sn = sn * r2 + 1.0 / 6227020800.0;
    sn = sn * r2 - 1.0 / 39916800.0;
    sn = sn * r2 + 1.0 / 362880.0;
    sn = sn * r2 - 1.0 / 5040.0;
    sn = sn * r2 + 1.0 / 120.0;
    sn = sn * r2 - 1.0 / 6.0;
    sn = sn * r2 + 1.0; sn *= r;
    double cs = 1.0 / 2432902008176640000.0;
    cs = cs * r2 - 1.0 / 6402373705728000.0;
    cs = cs * r2 + 1.0 / 20922789888000.0;
    cs = cs * r2 - 1.0 / 87178291200.0;
    cs = cs * r2 + 1.0 / 479001600.0;
    cs = cs * r2 - 1.0 / 3628800.0;
    cs = cs * r2 + 1.0 / 40320.0;
    cs = cs * r2 - 1.0 / 720.0;
    cs = cs * r2 + 1.0 / 24.0;
    cs = cs * r2 - 0.5;
    cs = cs * r2 + 1.0;
    c = (float)cs; s = (float)sn;
}

__device__ __forceinline__ void p0_prologue(Frame& F, const Args& args) {
    LAS float* scr = (LAS float*)(F.lds + RING_OFF + F.wave * 16384);
    const int gw = F.vcu * NWAVES + F.wave, NGW = F.G * NWAVES, lane = pg8::lane_id_now(), tid = F.wave * 64 + lane;
    constexpr int I_IN = (DM / 64) * (NIN / 32), I_A = (512 / 64) * (DM / 32), I_B = (256 / 64) * (DM / 32), I_O = (DM / 64) * (DM / 32), I_UP = (DM / 64) * (DFF / 32), I_DN = (DFF / 64) * (DM / 32), I_PP = (PLE / 64) * (DM / 32), I_PG = I_O;
    constexpr int NITEMS = I_IN + I_A + I_B + I_O + I_UP + I_DN + I_PP + I_PG;
    for (int it = gw; it < NITEMS; it += NGW) {
        int r = it;
        if (r < I_IN) { tr_win(F.w_in, F.Win_t, scr, r, lane); continue; } r -= I_IN;
        if (r < I_A) { tr_plain(F.w_bna, 512, DM, F.Wc1_t, YW, 0, nullptr, scr, r, lane); continue; } r -= I_A;
        if (r < I_B) { tr_plain(F.w_bdil, 256, DM, F.Wc1_t, YW, 512, nullptr, scr, r, lane); continue; } r -= I_B;
        if (r < I_O) { tr_plain(F.w_out, DM, DM, F.Wo_t, DM, 0, nullptr, scr, r, lane); continue; } r -= I_O;
        if (r < I_UP) { tr_plain(F.w_up, DM, DFF, F.Wup_t, DM, 0, F.g_mlp, scr, r, lane); continue; } r -= I_UP;
        if (r < I_DN) { tr_plain(F.w_down, DFF, DM, F.Wdn_t, DFF, 0, nullptr, scr, r, lane); continue; } r -= I_DN;
        if (r < I_PP) { tr_plain(F.w_pp, PLE, DM, F.Wc2_t, HPW, 0, nullptr, scr, r, lane); continue; } r -= I_PP;
        tr_plain(F.w_pg, DM, DM, F.Wc2_t, HPW, PLE, F.g_ple, scr, r, lane);
    }
    for (int m = gw; m < M; m += NGW) {
        const GAS f32x4* xr = (const GAS f32x4*)(F.x + (size_t)m * DM) + lane;
        f32x4 v[4]; float s = 0.f;
#pragma unroll
        for (int j = 0; j < 4; ++j) { v[j] = xr[64 * j]; s += (v[j].x * v[j].x + v[j].y * v[j].y) + (v[j].z * v[j].z + v[j].w * v[j].w); }
        const float rstd = 1.0f / sqrtf(wave_sum(s) * (1.f / DM) + RMS_EPS);
        GAS v2u* o8 = (GAS v2u*)(F.HP + (size_t)m * HPW + PLE) + lane;
#pragma unroll
        for (int j = 0; j < 4; ++j) { const f32x4 gg = *((const GAS f32x4*)F.g_mix + lane + 64 * j);
            v2u w; w.x = pk2(v[j].x * rstd * gg.x, v[j].y * rstd * gg.y); w.y = pk2(v[j].z * rstd * gg.z, v[j].w * rstd * gg.w); o8[64 * j] = w; }
        const f32x4 pv = *((const GAS f32x4*)(F.p + (size_t)m * PLE) + lane);
        v2u w; w.x = pk2(pv.x, pv.y); w.y = pk2(pv.z, pv.w); *((GAS v2u*)(F.HP + (size_t)m * HPW) + lane) = w;
    }
    { const long gt = (long)F.vcu * (NWAVES * 64) + tid, NT = (long)F.G * NWAVES * 64;
      for (long e = gt; e < (long)M * 32; e += NT) { const int row = (int)(e >> 5), f = (int)(e & 31);
          float c, s; sincos_rev((double)F.positions[row] * args.inv_freq[f], c, s);
          *(GAS f32x2*)(F.CS + e * 2) = (f32x2){c, s}; } }
}

__device__ __forceinline__ void ld8f(const bf16* p, float (&f)[8]) { const v4u v = *(const GAS v4u*)p;
    f[0] = pg8::bf_lo(v.x); f[1] = pg8::bf_hi(v.x); f[2] = pg8::bf_lo(v.y); f[3] = pg8::bf_hi(v.y); f[4] = pg8::bf_lo(v.z); f[5] = pg8::bf_hi(v.z); f[6] = pg8::bf_lo(v.w); f[7] = pg8::bf_hi(v.w); }

__device__ __forceinline__ void attn_naive(Frame& F) {
    const long gt = (long)F.vcu * (NWAVES * 64) + F.wave * 64 + pg8::lane_id_now(), NT = (long)F.G * NWAVES * 64;
    for (long item = gt; item < (long)M * 8; item += NT) {
        const int h = (int)(item & 7), tok = (int)(item >> 3);
        const int b = tok >> 12, t = tok & 4095, r = t >> 6, c = t & 63;
        const int rs = min(max(r - 4, 0), 56), cs = min(max(c - 8, 0), 48);
        float q[64], o[64];
        { const bf16* qp = F.QKV + (size_t)tok * NQKV + h * 64;
#pragma unroll
          for (int ch = 0; ch < 8; ++ch) { float f[8]; ld8f(qp + ch * 8, f);
#pragma unroll
              for (int e = 0; e < 8; ++e) { q[ch * 8 + e] = f[e]; o[ch * 8 + e] = 0.f; } } }
        float mx = -1e30f, l = 0.f;
        for (int kk = 0; kk < 128; ++kk) {
            const int kr = rs + (kk >> 4), kc = cs + (kk & 15);
            const bf16* kp = F.QKV + (size_t)((b << 12) + kr * 64 + kc) * NQKV + 512 + h * 64;
            float s = 0.f;
#pragma unroll
            for (int ch = 0; ch < 8; ++ch) { float f[8]; ld8f(kp + ch * 8, f);
#pragma unroll
                for (int e = 0; e < 8; ++e) s += q[ch * 8 + e] * f[e]; }
            s += F.rpb[h * 465 + (kr - r + 7) * 31 + (kc - c + 15)];
            const float mn = fmaxf(mx, s), a = __expf(mx - mn), pw = __expf(s - mn);
            l = l * a + pw; mx = mn;
            const bf16* vp = kp + 512;
#pragma unroll
            for (int ch = 0; ch < 8; ++ch) { float f[8]; ld8f(vp + ch * 8, f);
#pragma unroll
                for (int e = 0; e < 8; ++e) o[ch * 8 + e] = o[ch * 8 + e] * a + pw * f[e]; }
        }
        const float il = 1.f / l; bf16* yp = F.HP + (size_t)tok * HPW + PLE + h * 64;
#pragma unroll
        for (int ch = 0; ch < 8; ++ch) { v4u w; w.x = pk2(o[ch * 8 + 0] * il, o[ch * 8 + 1] * il); w.y = pk2(o[ch * 8 + 2] * il, o[ch * 8 + 3] * il); w.z = pk2(o[ch * 8 + 4] * il, o[ch * 8 + 5] * il); w.w = pk2(o[ch * 8 + 6] * il, o[ch * 8 + 7] * il);
            *(GAS v4u*)(yp + ch * 8) = w; }
    }
    for (long item = gt; item < (long)M * 4; item += NT) {
        const int slot = (int)(item & 3), tok = (int)(item >> 2);
        const int b = tok >> 12, t = tok & 4095;
        float q[64], o[64];
#pragma unroll
        for (int e = 0; e < 64; ++e) o[e] = 0.f;
        float mx = -1e30f, l = 0.f;
        for (int g = 0; g < 3; ++g) {
            const int sh = 2 * g, L = SEQ >> sh, rho = t & ((1 << sh) - 1), i = t >> sh, rowbase = (b << 12) + rho * L, hc = (g * 4 + slot) * 64;
            { const bf16* qp = F.QKV + (size_t)(rowbase + i) * NQKV + 1536 + hc;
#pragma unroll
              for (int ch = 0; ch < 8; ++ch) { float f[8]; ld8f(qp + ch * 8, f);
#pragma unroll
                  for (int e = 0; e < 8; ++e) q[ch * 8 + e] = f[e]; } }
            const int j0 = max(0, i - 64), j1 = min(L - 1, i + 64);
            for (int j = j0; j <= j1; ++j) {
                const bf16* kp = F.QKV + (size_t)(rowbase + j) * NQKV + 2304 + hc;
                float s = 0.f;
#pragma unroll
                for (int ch = 0; ch < 8; ++ch) { float f[8]; ld8f(kp + ch * 8, f);
#pragma unroll
                    for (int e = 0; e < 8; ++e) s += q[ch * 8 + e] * f[e]; }
                const float mn = fmaxf(mx, s), a = __expf(mx - mn), pw = __expf(s - mn);
                l = l * a + pw; mx = mn;
                const bf16* vp = kp + 768;
#pragma unroll
                for (int ch = 0; ch < 8; ++ch) { float f[8]; ld8f(vp + ch * 8, f);
#pragma unroll
                    for (int e = 0; e < 8; ++e) o[ch * 8 + e] = o[ch * 8 + e] * a + pw * f[e]; }
            }
        }
        const float il = 1.f / l; bf16* yp = F.HP + (size_t)tok * HPW + PLE + 512 + slot * 64;
#pragma unroll
        for (int ch = 0; ch < 8; ++ch) { v4u w; w.x = pk2(o[ch * 8 + 0] * il, o[ch * 8 + 1] * il); w.y = pk2(o[ch * 8 + 2] * il, o[ch * 8 + 3] * il); w.z = pk2(o[ch * 8 + 4] * il, o[ch * 8 + 5] * il); w.w = pk2(o[ch * 8 + 6] * il, o[ch * 8 + 7] * il);
            *(GAS v4u*)(yp + ch * 8) = w; }
    }
}

__device__ __forceinline__ void final_norm(Frame& F) {
    const int gw = F.vcu * NWAVES + F.wave, NGW = F.G * NWAVES, lane = pg8::lane_id_now();
    const float* ssq = F.SSQ + 2 * (size_t)M * 16;
    for (int m = gw; m < M; m += NGW) {
        const float r = row_rstd(ssq, (unsigned)m);
        GAS f32x4* xr = (GAS f32x4*)(F.out + (size_t)m * DM) + lane;
#pragma unroll
        for (int j = 0; j < 4; ++j) { const f32x4 gg = *((const GAS f32x4*)F.g_final + lane + 64 * j); f32x4 v = xr[64 * j]; v = v * r * gg; xr[64 * j] = v; }
    }
}


#ifdef MK_CHECK
constexpr size_t WS_SAVE = 498 * MiB;
constexpr int CW_CHK = 8192;
constexpr int NSAMP = 512;
__device__ __forceinline__ int samp_row(int s) { return 64 * s + ((s * 37) & 63); }
__device__ __forceinline__ float bfr(float f) { return __uint_as_float(f2bf(f) << 16); }
__device__ __forceinline__ float bfv(const bf16* p) { return __uint_as_float((unsigned)(*p) << 16); }
__device__ __forceinline__ void chk_report(gu32* ctl, int phase, float got, float exp, int s, int col) {
    const float dev = fabsf(got - exp) / (0.02f + 0.02f * fabsf(exp));
    const unsigned long long v = ((unsigned long long)__float_as_uint(dev) << 32) | (unsigned)((s << 13) | col);
    atomicMax((unsigned long long*)(ctl + CW_CHK + 2 * phase), v);
}
__device__ __forceinline__ float row_rstd_direct(const float* h) { float s = 0.f; for (int k = 0; k < DM; ++k) s += h[k] * h[k]; return 1.0f / sqrtf(s * (1.f / DM) + RMS_EPS); }
__global__ void __launch_bounds__(256) chk_kernel(Args args, int phase) {
    unsigned char* ws = args.ws; gu32* ctl = (gu32*)(ws + WS_CTL);
    const float* x = (const float*)args.in[0]; const float* pin = (const float*)args.in[1]; const int* positions = (const int*)args.in[2]; const float* g_mix = (const float*)args.in[3]; const float* w_in = (const float*)args.in[4];
    const float* w_bna = (const float*)args.in[6]; const float* w_bdil = (const float*)args.in[7]; const float* w_out = (const float*)args.in[8]; const float* g_mlp = (const float*)args.in[9];
    const float* w_up = (const float*)args.in[10]; const float* w_down = (const float*)args.in[11]; const float* g_ple = (const float*)args.in[12]; const float* w_pg = (const float*)args.in[13]; const float* w_pp = (const float*)args.in[14]; const float* g_final = (const float*)args.in[15];
    const bf16* HP = (const bf16*)(ws + WS_HP); const bf16* QKV = (const bf16*)(ws + WS_QKV); const bf16* GATES = (const bf16*)(ws + WS_GATES); const bf16* MIXED = (const bf16*)(ws + WS_MIXED); const bf16* U = (const bf16*)(ws + WS_U);
    float* SAVE = (float*)(ws + WS_SAVE); const float* out = args.out;
    const long gt = (long)blockIdx.x * 256 + threadIdx.x, NT = (long)gridDim.x * 256;
    if (phase == 100) {
        for (long e = gt; e < (long)NSAMP * DM; e += NT) { const int s = (int)(e >> 10), c = (int)(e & 1023); SAVE[e] = out[(size_t)samp_row(s) * DM + c]; }
    } else if (phase == 0) {
        for (long e = gt; e < (long)NSAMP * HPW; e += NT) { const int s = (int)(e / HPW), c = (int)(e % HPW), row = samp_row(s);
            float exp; if (c < PLE) exp = pin[(size_t)row * PLE + c]; else { const float r = row_rstd_direct(x + (size_t)row * DM); exp = x[(size_t)row * DM + c - PLE] * r * g_mix[c - PLE]; }
            chk_report(ctl, 0, bfv(HP + (size_t)row * HPW + c), exp, s, c); }
    } else if (phase == 1) {
        for (long e = gt; e < (long)NSAMP * NIN; e += NT) { const int s = (int)(e / NIN), c = (int)(e % NIN), row = samp_row(s);
            const bf16* a = HP + (size_t)row * HPW + PLE;
            float v = 0.f, v2 = 0.f; const bool rot = (c >= 1536 && c < 3072); const int c2 = rot ? (c ^ 32) : c;
            for (int k = 0; k < DM; ++k) { const float av = bfv(a + k); v += av * bfr(w_in[(size_t)k * NIN + c]); if (rot) v2 += av * bfr(w_in[(size_t)k * NIN + c2]); }
            float exp, got;
            if (c >= 3840) { exp = 1.f / (1.f + expf(-v)); got = bfv(GATES + (size_t)row * NGATE + (c - 3840)); }
            else { int sh = 0; if (c >= 1536) sh = 2 * (((c - 1536) % 768) / 256);
                if (rot) { const int d = c & 63, f = d & 31; const double ang = (double)positions[row] * args.inv_freq[f]; const float cs = (float)cos(ang), sn = (float)sin(ang);
                    exp = (d < 32) ? (v * cs - v2 * sn) : (v * cs + v2 * sn); if (c < 2304) exp *= 0.125f; }
                else exp = (c < 512) ? v * 0.125f : v;
                got = bfv(QKV + (size_t)perm_row(row, sh) * NQKV + c); }
            chk_report(ctl, 1, got, exp, s, c); }
    } else if (phase == 3) {
        for (long e = gt; e < (long)NSAMP * DM; e += NT) { const int s = (int)(e >> 10), c = (int)(e & 1023), row = samp_row(s);
            const bf16* y = HP + (size_t)row * HPW + PLE; float t1 = 0.f, t2 = 0.f;
            for (int k = 0; k < 512; ++k) t1 += bfv(y + k) * bfr(w_bna[(size_t)k * DM + c]);
            for (int k = 0; k < 256; ++k) t2 += bfv(y + 512 + k) * bfr(w_bdil[(size_t)k * DM + c]);
            const float exp = bfv(GATES + (size_t)row * NGATE + c) * t1 + bfv(GATES + (size_t)row * NGATE + 1024 + c) * t2;
            chk_report(ctl, 3, bfv(MIXED + (size_t)row * DM + c), exp, s, c); }
    } else if (phase == 4) {
        for (long e = gt; e < (long)NSAMP * DM; e += NT) { const int s = (int)(e >> 10), c = (int)(e & 1023), row = samp_row(s);
            float v = 0.f; for (int k = 0; k < DM; ++k) v += bfv(MIXED + (size_t)row * DM + k) * bfr(w_out[(size_t)k * DM + c]);
            chk_report(ctl, 4, out[(size_t)row * DM + c], x[(size_t)row * DM + c] + v, s, c); }
    } else if (phase == 5) {
        for (long e = gt; e < (long)NSAMP * DFF; e += NT) { const int s = (int)(e >> 12), c = (int)(e & 4095), row = samp_row(s);
            const float r = row_rstd_direct(out + (size_t)row * DM); float v = 0.f;
            for (int k = 0; k < DM; ++k) v += bfv(HP + (size_t)row * HPW + PLE + k) * bfr(w_up[(size_t)k * DFF + c] * g_mlp[k]);
            v = fmaxf(v * r, 0.f); chk_report(ctl, 5, bfv(U + (size_t)row * DFF + c), v * v, s, c); }
    } else if (phase == 6) {
        for (long e = gt; e < (long)NSAMP * DM; e += NT) { const int s = (int)(e >> 10), c = (int)(e & 1023), row = samp_row(s);
            float v = 0.f; for (int k = 0; k < DFF; ++k) v += bfv(U + (size_t)row * DFF + k) * bfr(w_down[(size_t)k * DM + c]);
            chk_report(ctl, 6, out[(size_t)row * DM + c], SAVE[e] + v, s, c); }
    } else if (phase == 7) {
        for (long e = gt; e < (long)NSAMP * DM; e += NT) { const int s = (int)(e >> 10), c = (int)(e & 1023), row = samp_row(s);
            const float r = row_rstd_direct(SAVE + (size_t)s * DM); float v = 0.f, t = 0.f;
            for (int k = 0; k < DM; ++k) v += bfv(HP + (size_t)row * HPW + PLE + k) * bfr(w_pg[(size_t)k * DM + c] * g_ple[k]);
            for (int k = 0; k < PLE; ++k) t += bfv(HP + (size_t)row * HPW + k) * bfr(w_pp[(size_t)k * DM + c]);
            chk_report(ctl, 7, out[(size_t)row * DM + c], SAVE[e] + t / (1.f + expf(-v * r)), s, c); }
    } else if (phase == 8) {
        for (long e = gt; e < (long)NSAMP * DM; e += NT) { const int s = (int)(e >> 10), c = (int)(e & 1023), row = samp_row(s);
            const float r = row_rstd_direct(SAVE + (size_t)s * DM); chk_report(ctl, 8, out[(size_t)row * DM + c], SAVE[e] * r * g_final[c], s, c); }
    } else if (phase == 300) {
        unsigned nq = 0, ng = 0;
        for (long e = gt; e < (long)M * NQKV; e += NT) nq += (QKV[e] == 0xAAAAu) ? 1u : 0u;
        for (long e = gt; e < (long)M * NGATE; e += NT) { if (GATES[e] == 0xAAAAu) { ng += 1u; atomicOr((unsigned*)(ctl + CW_CHK + 43), (unsigned)(e & 2047)); atomicAnd((unsigned*)(ctl + CW_CHK + 44), (unsigned)(e & 2047)); atomicMax((unsigned*)(ctl + CW_CHK + 42), (unsigned)(e >> 11)); } }
        if (nq) atomicAdd((unsigned*)(ctl + CW_CHK + 39), nq); if (ng) atomicAdd((unsigned*)(ctl + CW_CHK + 40), ng);
    } else if (phase == 200) {
        if (gt == 0) { int d1 = 9, d2 = 0, E = 3;
            for (int ph = 0; ph < 9; ++ph) { const unsigned long long v = *((unsigned long long*)(ctl + CW_CHK + 2 * ph)); const float dev = __uint_as_float((unsigned)(v >> 32));
                if (dev > 1.f) { d1 = ph; const int lg = (int)floorf(log2f(dev)); d2 = lg > 9 ? 9 : lg; const unsigned loc = (unsigned)v;
#if MK_CHECK == 1
                    E = 3 + (int)((loc & 8191) >> 8);
#elif MK_CHECK == 2
                    E = 3 + (int)(((loc & 8191) & 255) >> 4);
#elif MK_CHECK == 3
                    E = 3 + (int)((loc >> 13) >> 5);
#else
                    E = 3 + (int)((loc >> 13) & 31);
#endif
                    break; } }
            float X = (float)(10 * d1 + d2); for (int i = 0; i < E; ++i) X *= 10.f;
#if MK_CHECK >= 5
            { const unsigned long long v = *((unsigned long long*)(ctl + CW_CHK + 2 * 1)); const unsigned loc = (unsigned)v; const int s_ = (int)(loc >> 13), c_ = (int)(loc & 8191), row_ = samp_row(s_);
              const float got_ = bfv(GATES + (size_t)row_ * NGATE + (c_ - 3840));
#if MK_CHECK == 5
              { const unsigned ng_ = *(unsigned*)(ctl + CW_CHK + 40), nq_ = *(unsigned*)(ctl + CW_CHK + 39); X = (float)(31 - __clz((int)(ng_ + 1u)) + 10); const int E_ = 3 + 31 - __clz((int)(nq_ + 1u)); for (int i = 0; i < E_; ++i) X *= 10.f; }
#elif MK_CHECK == 6
              X = (float)(*(unsigned*)(ctl + CW_CHK + 42)) * 1e10f;
#elif MK_CHECK == 7
              X = (float)(*(unsigned*)(ctl + CW_CHK + 43)) * 1e10f;
#else
              X = __uint_as_float((unsigned)(v >> 32)) * 1e10f;
#endif
            }
#endif
            ((float*)args.out)[0] = X; }
    }
}
#endif

__global__ void __launch_bounds__(NWAVES * 64, 2) skel_fwd(Args args) {
    extern __shared__ __attribute__((aligned(16))) unsigned char lds[];
    Frame F;
    F.lds = (LAS unsigned char*)lds;
    F.MISC = (volatile LAS unsigned*)(F.lds + MISC_OFF);
    F.wave = __builtin_amdgcn_readfirstlane((int)threadIdx.x >> 6);
    F.G = gridDim.x; { const int bx = blockIdx.x; F.vcu = (F.G % 8 == 0) ? (bx % 8) * (F.G / 8) + bx / 8 : bx; }
#define GRID_BAR(seam) do { if (N_LAUNCHES == PER_PHASE) { if (F.wave == 0 && pg8::lane_id_now() == 0) __hip_atomic_store(F.ctl + CW_TMO, 0xBADBA0u | (unsigned)(seam), RLX_AGENT); } \
    else { xcd_barrier(bar, F.wave); } } while (0)
    unsigned char* ws = args.ws;
    F.ctl = (gu32*)(ws + WS_CTL);
    F.x = (const float*)args.in[0]; F.p = (const float*)args.in[1]; F.positions = (const int*)args.in[2]; F.g_mix = (const float*)args.in[3]; F.w_in = (const float*)args.in[4];
    F.rpb = (const float*)args.in[5]; F.w_bna = (const float*)args.in[6]; F.w_bdil = (const float*)args.in[7]; F.w_out = (const float*)args.in[8]; F.g_mlp = (const float*)args.in[9];
    F.w_up = (const float*)args.in[10]; F.w_down = (const float*)args.in[11]; F.g_ple = (const float*)args.in[12]; F.w_pg = (const float*)args.in[13]; F.w_pp = (const float*)args.in[14]; F.g_final = (const float*)args.in[15];
    F.out = args.out;
    F.Win_t = (bf16*)(ws + WS_WIN); F.Wc1_t = (bf16*)(ws + WS_WC1); F.Wo_t = (bf16*)(ws + WS_WO); F.Wup_t = (bf16*)(ws + WS_WUP); F.Wdn_t = (bf16*)(ws + WS_WDN); F.Wc2_t = (bf16*)(ws + WS_WC2);
    F.CS = (float*)(ws + WS_CS); F.SSQ = (float*)(ws + WS_SSQ);
    F.HP = (bf16*)(ws + WS_HP); F.QKV = (bf16*)(ws + WS_QKV); F.GATES = (bf16*)(ws + WS_GATES); F.MIXED = (bf16*)(ws + WS_MIXED); F.U = (bf16*)(ws + WS_U); F.T2 = (bf16*)(ws + WS_T2);
    for (int u = (int)threadIdx.x; u < (LDS_BYTES - LDSCTL_OFF) / 4; u += NWAVES * 64) ((LAS unsigned*)(F.lds + LDSCTL_OFF))[u] = 0u;
    __syncthreads();
    const int bli = (N_LAUNCHES == PER_PHASE) ? 0 : args.li;
    XcdBarrier bar; bar.bar = (unsigned*)(F.ctl + CW_BAR) + bli * XCD_BAR_WORDS; bar.x = 0; bar.st = nullptr;
    if (N_LAUNCHES != PER_PHASE)
        bar = xcd_barrier_post((unsigned*)(F.ctl + CW_BAR) + bli * XCD_BAR_WORDS, F.MISC + 8);

    const int lo = args.ph_lo, hi = args.ph_hi;
#define IN(k) (lo <= (k) && (k) < hi)
#define BOTH(k) (IN(k) && IN((k) + 1))
    const int cid = (int)blockIdx.x;

    if (IN(0)) { p0_prologue(F, args); if (BOTH(0)) GRID_BAR(0); }

    if (IN(1)) {
        pg8::Gemm g{F.HP + PLE, F.Win_t, M, NIN, DM, HPW}; pg8::StaticOrder S; S.init(M, NIN, F.G, cid);
        EpiIn E{F.QKV, F.GATES, F.CS};
        pg8::gemm_phase<EpiIn, pg8::StaticOrder, PG8_ALIGN, PG8_SP2>(F.lds + RING_OFF, g, S, E, F.wave);
        if (BOTH(1)) GRID_BAR(1);
    }
    if (IN(2)) { attn_naive(F); if (BOTH(2)) GRID_BAR(2); }
    if (IN(3)) {
        pg8::Gemm g{F.HP + PLE, F.Wc1_t, M, DM, YW, HPW}; pg8::StaticOrder S; S.init(M, DM, F.G, cid);
        EpiMix E{F.GATES, F.MIXED};
        pg8::gemm_phase<EpiMix, pg8::StaticOrder, PG8_ALIGN, PG8_SP2>(F.lds + RING_OFF, g, S, E, F.wave);
        if (BOTH(3)) GRID_BAR(3);
    }
    if (IN(4)) {
        pg8::Gemm g{F.MIXED, F.Wo_t, M, DM, DM, DM}; pg8::StaticOrder S; S.init(M, DM, F.G, cid);
        EpiRes E{F.x, F.out, F.HP + PLE, F.SSQ};
        pg8::gemm_phase<EpiRes, pg8::StaticOrder, PG8_ALIGN, PG8_SP2>(F.lds + RING_OFF, g, S, E, F.wave);
        if (BOTH(4)) GRID_BAR(4);
    }
    if (IN(5)) {
        pg8::Gemm g{F.HP + PLE, F.Wup_t, M, DFF, DM, HPW}; pg8::StaticOrder S; S.init(M, DFF, F.G, cid);
        EpiUp E{F.SSQ, F.U};
        pg8::gemm_phase<EpiUp, pg8::StaticOrder, PG8_ALIGN, PG8_SP2>(F.lds + RING_OFF, g, S, E, F.wave);
        if (BOTH(5)) GRID_BAR(5);
    }
    if (IN(6)) {
        pg8::Gemm g{F.U, F.Wdn_t, M, DM, DFF, DFF}; pg8::StaticOrder S; S.init(M, DM, F.G, cid);
        EpiRes E{F.out, F.out, F.HP + PLE, F.SSQ + (size_t)M * 16};
        pg8::gemm_phase<EpiRes, pg8::StaticOrder, PG8_ALIGN, PG8_SP2>(F.lds + RING_OFF, g, S, E, F.wave);
        if (BOTH(6)) GRID_BAR(6);
    }
    if (IN(7)) {
        pg8::Gemm g{F.HP, F.Wc2_t, M, DM, HPW, HPW}; pg8::StaticOrder S; S.init(M, DM, F.G, cid);
        EpiPle E{F.T2, F.SSQ + (size_t)M * 16, F.out, F.SSQ + 2 * (size_t)M * 16};
        pg8::gemm_phase<EpiPle, pg8::StaticOrder, PG8_ALIGN, PG8_SP2>(F.lds + RING_OFF, g, S, E, F.wave);
        if (BOTH(7)) GRID_BAR(7);
    }
    if (IN(8)) { final_norm(F); }
#undef IN
#undef BOTH
}

extern "C" void kernel_launch(void* const* d_in, const int* in_sizes, int n_in, void* d_out, int out_size, void* d_ws, size_t ws_size, hipStream_t stream) {
    static int grid = 0;
    if (grid == 0) {
        if (n_in != 16 || in_sizes[0] != M * DM || out_size != M * DM || ws_size < WS_END) { fprintf(stderr, "kernel_launch: shape/workspace mismatch: n_in %d in0 %d out %d ws %zu (need %zu); nothing launched\n", n_in, n_in > 0 ? in_sizes[0] : -1, out_size, ws_size, (size_t)WS_END); grid = -1; return; }
        int dev = 0, cus = 0, per_cu = 0;
        if (hipGetDevice(&dev) != hipSuccess || hipDeviceGetAttribute(&cus, hipDeviceAttributeMultiprocessorCount, dev) != hipSuccess) { fprintf(stderr, "kernel_launch: device query failed\n"); grid = -1; return; }
        if (hipFuncSetAttribute((const void*)skel_fwd, hipFuncAttributeMaxDynamicSharedMemorySize, LDS_BYTES) != hipSuccess) { fprintf(stderr, "kernel_launch: hipFuncSetAttribute failed\n"); grid = -1; return; }
        if (hipOccupancyMaxActiveBlocksPerMultiprocessor(&per_cu, (const void*)skel_fwd, NWAVES * 64, LDS_BYTES) != hipSuccess || per_cu < 1)
            fprintf(stderr, "kernel_launch: note: occupancy query reports %d workgroups per CU\n", per_cu);
        (void)hipGetLastError();
        grid = cus;
    }
    if (grid < 0) return;
#ifdef MK_CHECK
    (void)hipMemsetAsync((char*)d_ws + WS_QKV, 0xAA, 368 * MiB, stream);
#endif
    if (hipMemsetAsync((char*)d_ws + WS_CTL, 0, CTL_ZERO_BYTES, stream) != hipSuccess) { fprintf(stderr, "kernel_launch: hipMemsetAsync failed\n"); return; }
    Args a{};
    for (int i = 0; i < 16; ++i) a.in[i] = d_in[i];
    a.out = (float*)d_out; a.ws = (unsigned char*)d_ws;
    for (int f = 0; f < 32; ++f) a.inv_freq[f] = std::pow(10000.0, -(double)f / 32.0);
    static_assert(N_LAUNCHES == 1 || N_LAUNCHES == PER_PHASE, "MK_N_LAUNCHES is 1 or 9");
    for (int li = 0; li < N_LAUNCHES; ++li) {
        a.ph_lo = (N_LAUNCHES == PER_PHASE) ? li : 0; a.ph_hi = (N_LAUNCHES == PER_PHASE) ? li + 1 : PER_PHASE; a.li = (N_LAUNCHES == PER_PHASE) ? 0 : li;
        hipLaunchKernelGGL(skel_fwd, dim3(grid), dim3(NWAVES * 64), LDS_BYTES, stream, a);
        const hipError_t le = hipPeekAtLastError();
        if (le != hipSuccess) { fprintf(stderr, "kernel_launch: launch %d failed: %s\n", li, hipGetErrorName(le)); break; }
#ifdef MK_CHECK
        if (li == 0 || li == 1 || li == 3 || li == 4 || li == 5 || li == 6 || li == 7 || li == 8) hipLaunchKernelGGL(chk_kernel, dim3(1024), dim3(256), 0, stream, a, li);
        if (li == 1) hipLaunchKernelGGL(chk_kernel, dim3(1024), dim3(256), 0, stream, a, 300);
        if (li == 5 || li == 6 || li == 7) hipLaunchKernelGGL(chk_kernel, dim3(1024), dim3(256), 0, stream, a, 100);
        if (li == 8) hipLaunchKernelGGL(chk_kernel, dim3(1), dim3(256), 0, stream, a, 200);
#endif
    }
}
```

```cpp
#include <hip/hip_runtime.h>
#include <cstdio>
#include <cstdint>
#include <cmath>

#ifndef MK_N_LAUNCHES
#define MK_N_LAUNCHES 1
#endif

namespace pg8 {
#define PG8_LAS __attribute__((address_space(3)))
typedef unsigned short bf16_t;
typedef short bf16x8 __attribute__((ext_vector_type(8)));
typedef float f32x4 __attribute__((ext_vector_type(4)));
typedef unsigned u32x4 __attribute__((ext_vector_type(4)));
constexpr int BM = 256, BK = 64, HALF = 128, HTB = HALF * BK * 2  , STAGE_BYTES = 8 * HTB, NXCD = 8, WGM = 8;

__host__ __device__ __forceinline__ int lds_byte(int r, int c) { const int st = (r >> 4) * 2 + (c >> 5), rr = r & 15, cc = c & 31, ob = rr * 64 + cc * 2; return st * 1024 + (ob ^ (((ob >> 9) & 1) << 5)); }
__host__ __device__ __forceinline__ void stage_rc(int b, int& R, int& C) { const int st = b / 1024, sb = b % 1024, swz = sb ^ (((sb >> 9) & 1) << 5); R = (st >> 1) * 16 + swz / 64; C = (st & 1) * 32 + (swz % 64) / 2; }
__host__ __device__ __forceinline__ int perm32(int rho) { const int n = rho >> 4, i = rho & 15; return 8 * (i >> 2) + 4 * n + (i & 3); }

struct Unit { int pm, pn; };
struct Gemm { const bf16_t* A; const bf16_t* Bt; int M, N, K, lda; };

struct StaticOrder {
    int nM, nN, nwg, G, c;
    __host__ __device__ void init(int M, int N, int G_, int c_) { nM = M / BM; nN = N / BM; nwg = nM * nN; G = G_; c = c_; }
    __host__ __device__ bool next(int i, Unit& u) const {
        const long L = (long)i * G + c; if (L >= nwg) return false;
        int wgid = (int)L; { const int q = nwg / NXCD, r = nwg % NXCD, xcd = wgid % NXCD, off = wgid / NXCD; wgid = (xcd < r ? xcd * (q + 1) : r * (q + 1) + (xcd - r) * q) + off; }
        const int nig = WGM * nN, gid = wgid / nig, fm = gid * WGM, gsz = (nM - fm) < WGM ? (nM - fm) : WGM;
        u.pm = fm + ((wgid % nig) % gsz); u.pn = (wgid % nig) / gsz; return true;
    }
    __device__ __forceinline__ void a_ready(const Unit&) const {}
    __device__ __forceinline__ void done(const Unit&) const {}
};

__device__ __forceinline__ int lane_id_now() { int l; asm volatile("v_mbcnt_lo_u32_b32 %0, -1, 0\n\tv_mbcnt_hi_u32_b32 %0, -1, %0" : "=v"(l)); return l; }
typedef float f32x2_t __attribute__((ext_vector_type(2))); typedef __bf16 bf16x2_t __attribute__((ext_vector_type(2)));
__device__ __forceinline__ unsigned cvt_pk_bf16(float lo, float hi) { f32x2_t v = {lo, hi}; bf16x2_t b = __builtin_convertvector(v, bf16x2_t); return __builtin_bit_cast(unsigned, b); }
__device__ __forceinline__ u32x4 pack8(const f32x4 a, const f32x4 b) { u32x4 w; w.x = cvt_pk_bf16(a[0], a[1]); w.y = cvt_pk_bf16(a[2], a[3]); w.z = cvt_pk_bf16(b[0], b[1]); w.w = cvt_pk_bf16(b[2], b[3]); return w; }
__device__ __forceinline__ float bf_lo(unsigned u) { return __uint_as_float(u << 16); }
__device__ __forceinline__ float bf_hi(unsigned u) { return __uint_as_float(u & 0xffff0000u); }
__device__ __forceinline__ void unpack8(const u32x4 w, f32x4& a, f32x4& b) { a = (f32x4){bf_lo(w.x), bf_hi(w.x), bf_lo(w.y), bf_hi(w.y)}; b = (f32x4){bf_lo(w.z), bf_hi(w.z), bf_lo(w.w), bf_hi(w.w)}; }

template <class Epi, class Sched, bool ALIGN_EPI = false, bool SP2 = false>
__device__ __forceinline__ void gemm_phase(PG8_LAS unsigned char* lds, const Gemm g, const Sched& S, const Epi& E, const int wid) {
    const int lane = lane_id_now(), tid = wid * 64 + lane, wr = wid >> 2, wc = wid & 3, fr = lane & 15, fq = lane >> 4;
    const int K = g.K, nt = K / BK, lda = g.lda;
    unsigned voffA[2], voffB[2];
#pragma unroll
    for (int i = 0; i < 2; ++i) { int R, C; stage_rc(tid * 16 + i * 8192, R, C); const int Rb = Epi::PERM ? ((R & ~31) + perm32(R & 31)) : R;
        voffA[i] = (unsigned)(R * lda + C) * 2u; voffB[i] = (unsigned)(Rb * K + C) * 2u; }
    const size_t kstep = (size_t)(BK * 2);
    const size_t hstepA = (size_t)HALF * lda * 2, hstepB = (size_t)HALF * K * 2;
    const size_t tstepA = 2 * hstepA, tstepB = 2 * hstepB;
    const unsigned ldsw = (unsigned)wid * 1024u;
    const int aoff = lds_byte(wr * 64 + fr, fq * 8), boff = lds_byte(wc * 32 + fr, fq * 8);
#define PG8_SA(b, h) (((b) * 2 + (h)) * HTB)
#define PG8_SB(b, h) ((4 + (b) * 2 + (h)) * HTB)
#define PG8_STAGE(bufoff, gbase, voff) do { _Pragma("unroll") for (int _i = 0; _i < 2; ++_i) \
        __builtin_amdgcn_global_load_lds((const unsigned*)((const char*)(gbase) + (voff)[_i]), (PG8_LAS unsigned*)(lds + (bufoff) + ldsw + _i * 8192), 16, 0, 0); } while (0)
#define PG8_LDA(dst, b, h) do { _Pragma("unroll") for (int m = 0; m < 4; ++m) _Pragma("unroll") for (int k = 0; k < 2; ++k) dst[m][k] = *(const PG8_LAS bf16x8*)(lds + PG8_SA(b, h) + aoff + m * 2048 + k * 1024); } while (0)
#define PG8_LDB(dst, b, h) do { _Pragma("unroll") for (int n = 0; n < 2; ++n) _Pragma("unroll") for (int k = 0; k < 2; ++k) dst[n][k] = *(const PG8_LAS bf16x8*)(lds + PG8_SB(b, h) + boff + n * 2048 + k * 1024); } while (0)
#define PG8_MMA(ai, bj, At, Bt) do { __builtin_amdgcn_s_setprio(1); _Pragma("unroll") for (int m = 0; m < 4; ++m) _Pragma("unroll") for (int n = 0; n < 2; ++n) _Pragma("unroll") for (int k = 0; k < 2; ++k) \
        acc[ai][bj][m][n] = __builtin_amdgcn_mfma_f32_16x16x32_bf16(Bt[n][k], At[m][k], acc[ai][bj][m][n], 0, 0, 0); __builtin_amdgcn_s_setprio(0); } while (0)
#define PG8_WAIT_V(n) asm volatile("s_waitcnt vmcnt(" #n ")" ::: "memory")
#define PG8_WAIT_L(n) asm volatile("s_waitcnt lgkmcnt(" #n ")" ::: "memory")
#define PG8_BAR __builtin_amdgcn_s_barrier()
#define PG8_SCHED __builtin_amdgcn_sched_barrier(0)
    Unit cur, nxt; int ui = 0;
    if (!S.next(0, cur)) return;
    f32x4 acc[2][2][4][2];
#pragma unroll
    for (int a = 0; a < 2; ++a)
#pragma unroll
        for (int b = 0; b < 2; ++b)
#pragma unroll
            for (int m = 0; m < 4; ++m)
#pragma unroll
                for (int n = 0; n < 2; ++n) acc[a][b][m][n] = (f32x4){0.f, 0.f, 0.f, 0.f};
    bf16x8 At[4][2], B0[2][2], B1[2][2];
    const char* cA = (const char*)g.A + (size_t)cur.pm * tstepA; const char* cB = (const char*)g.Bt + (size_t)cur.pn * tstepB;
    S.a_ready(cur);
    if constexpr (SP2) {
        PG8_STAGE(PG8_SB(0, 0), cB, voffB); PG8_STAGE(PG8_SB(0, 1), cB + hstepB, voffB); PG8_STAGE(PG8_SA(0, 0), cA, voffA); PG8_STAGE(PG8_SA(0, 1), cA + hstepA, voffA);
        if (wr == 1) PG8_BAR;
        PG8_WAIT_V(2); PG8_BAR;
        PG8_STAGE(PG8_SB(1, 0), cB + kstep, voffB); PG8_STAGE(PG8_SA(1, 0), cA + kstep, voffA); PG8_STAGE(PG8_SB(1, 1), cB + hstepB + kstep, voffB);
        PG8_WAIT_V(6); PG8_BAR;
    } else {
        PG8_STAGE(PG8_SB(0, 0), cB, voffB); PG8_STAGE(PG8_SA(0, 0), cA, voffA); PG8_STAGE(PG8_SB(0, 1), cB + hstepB, voffB); PG8_STAGE(PG8_SA(0, 1), cA + hstepA, voffA);
        if (wr == 1) PG8_BAR;
        PG8_WAIT_V(4); PG8_BAR;
        PG8_STAGE(PG8_SB(1, 0), cB + kstep, voffB); PG8_STAGE(PG8_SA(1, 0), cA + kstep, voffA); PG8_STAGE(PG8_SB(1, 1), cB + hstepB + kstep, voffB);
        PG8_WAIT_V(6); PG8_BAR;
    }
    for (;;) {
        const bool has_next = S.next(ui + 1, nxt);
        const char* nA = has_next ? (const char*)g.A + (size_t)nxt.pm * tstepA : cA; const char* nB = has_next ? (const char*)g.Bt + (size_t)nxt.pn * tstepB : cB;
        for (int t = 0; t < nt; t += 2) {
            if constexpr (Epi::HAS_MID) { if (t == Epi::MID_T) E.mid(acc, cur, wr, wc, fr, fq); }
            const bool last = (t == nt - 2);
            const char* a1 = cA + (size_t)(t + 1) * kstep;
            const char* a2 = last ? nA : cA + (size_t)(t + 2) * kstep; const char* b2 = last ? nB : cB + (size_t)(t + 2) * kstep;
            const char* a3 = a2 + kstep; const char* b3 = b2 + kstep;
            if (last && has_next) S.a_ready(nxt);
            if constexpr (SP2) {
            PG8_LDB(B0, 0, 0); PG8_LDB(B1, 0, 1); PG8_SCHED; PG8_LDA(At, 0, 0); PG8_STAGE(PG8_SA(1, 1), a1 + hstepA, voffA);
            PG8_WAIT_V(8); PG8_WAIT_L(0); PG8_BAR; PG8_MMA(0, 0, At, B0); PG8_MMA(0, 1, At, B1); PG8_BAR; PG8_SCHED;
            PG8_LDA(At, 0, 1); PG8_STAGE(PG8_SB(0, 0), b2, voffB); PG8_STAGE(PG8_SB(0, 1), b2 + hstepB, voffB); PG8_STAGE(PG8_SA(0, 0), a2, voffA);
            PG8_WAIT_V(8); PG8_WAIT_L(0); PG8_BAR; PG8_MMA(1, 0, At, B0); PG8_MMA(1, 1, At, B1); PG8_BAR; PG8_SCHED;
            PG8_LDB(B0, 1, 0); PG8_LDB(B1, 1, 1); PG8_SCHED; PG8_LDA(At, 1, 0); PG8_STAGE(PG8_SA(0, 1), a2 + hstepA, voffA);
            PG8_WAIT_V(8); PG8_WAIT_L(0); PG8_BAR; PG8_MMA(0, 0, At, B0); PG8_MMA(0, 1, At, B1); PG8_BAR; PG8_SCHED;
            PG8_LDA(At, 1, 1); PG8_STAGE(PG8_SB(1, 0), b3, voffB); PG8_STAGE(PG8_SB(1, 1), b3 + hstepB, voffB); PG8_STAGE(PG8_SA(1, 0), a3, voffA);
            PG8_WAIT_V(8); PG8_WAIT_L(0); PG8_BAR; PG8_MMA(1, 0, At, B0); PG8_MMA(1, 1, At, B1); PG8_BAR; PG8_SCHED;
            } else {
            PG8_LDB(B0, 0, 0); PG8_SCHED; PG8_LDA(At, 0, 0); PG8_STAGE(PG8_SA(1, 1), a1 + hstepA, voffA);
            PG8_WAIT_L(8); PG8_BAR; PG8_WAIT_L(0); PG8_MMA(0, 0, At, B0); PG8_BAR; PG8_SCHED;
            PG8_LDB(B1, 0, 1); PG8_STAGE(PG8_SB(0, 0), b2, voffB);
            PG8_BAR; PG8_WAIT_L(0); PG8_MMA(0, 1, At, B1); PG8_BAR;
            PG8_LDA(At, 0, 1); PG8_STAGE(PG8_SA(0, 0), a2, voffA);
            PG8_BAR; PG8_WAIT_L(0); PG8_MMA(1, 0, At, B0); PG8_BAR; PG8_SCHED;
            PG8_STAGE(PG8_SB(0, 1), b2 + hstepB, voffB);
            PG8_WAIT_V(6); PG8_BAR; PG8_MMA(1, 1, At, B1); PG8_BAR;
            PG8_LDB(B0, 1, 0); PG8_SCHED; PG8_LDA(At, 1, 0); PG8_STAGE(PG8_SA(0, 1), a2 + hstepA, voffA);
            PG8_WAIT_L(8); PG8_BAR; PG8_WAIT_L(0); PG8_MMA(0, 0, At, B0); PG8_BAR; PG8_SCHED;
            PG8_LDB(B1, 1, 1); PG8_STAGE(PG8_SB(1, 0), b3, voffB);
            PG8_BAR; PG8_WAIT_L(0); PG8_MMA(0, 1, At, B1); PG8_BAR;
            PG8_LDA(At, 1, 1); PG8_STAGE(PG8_SA(1, 0), a3, voffA);
            PG8_BAR; PG8_WAIT_L(0); PG8_MMA(1, 0, At, B0); PG8_BAR; PG8_SCHED;
            PG8_STAGE(PG8_SB(1, 1), b3 + hstepB, voffB);
            PG8_WAIT_V(6); PG8_BAR; PG8_MMA(1, 1, At, B1); PG8_BAR;
            }
        }
        if constexpr (ALIGN_EPI) { if (wr == 0) PG8_BAR; }
        E(acc, cur, wr, wc, fr, fq); S.done(cur);
        if (!has_next) break;
#pragma unroll
        for (int a = 0; a < 2; ++a)
#pragma unroll
            for (int b = 0; b < 2; ++b)
#pragma unroll
                for (int m = 0; m < 4; ++m)
#pragma unroll
                    for (int n = 0; n < 2; ++n) acc[a][b][m][n] = (f32x4){0.f, 0.f, 0.f, 0.f};
        cur = nxt; cA = nA; cB = nB; ++ui;
        if constexpr (ALIGN_EPI) { if (wr == 1) PG8_BAR; }
    }
    PG8_WAIT_V(0);
    if constexpr (!ALIGN_EPI) { if (wr == 0) PG8_BAR; }
    PG8_BAR;
#undef PG8_SA
#undef PG8_SB
#undef PG8_STAGE
#undef PG8_LDA
#undef PG8_LDB
#undef PG8_MMA
#undef PG8_WAIT_V
#undef PG8_WAIT_L
#undef PG8_BAR
#undef PG8_SCHED
}
}

#ifndef PG8_SP2
#define PG8_SP2 true
#endif
#ifndef PG8_ALIGN
#define PG8_ALIGN true
#endif

constexpr int NWAVES = 8;
constexpr int N_LAUNCHES = MK_N_LAUNCHES;
constexpr int PER_PHASE = 9;
constexpr int BATCH = 8, SEQ = 4096, DM = 1024, M = BATCH * SEQ;
constexpr int NQKV = 3840, NGATE = 2048, NIN = 5888, DFF = 4096, PLE = 256, HPW = 1280, YW = 768;
constexpr float RMS_EPS = 1e-6f;
constexpr float LOG2E = 1.4426950408889634f, QSCALE = 0.125f * LOG2E;

constexpr size_t MiB = 1u << 20;
constexpr size_t WS_CTL = 0, CTL_ZERO_BYTES = 1 * MiB;
constexpr size_t WS_WIN = 1 * MiB, WS_WC1 = 13 * MiB, WS_WO = 15 * MiB, WS_WUP = 17 * MiB, WS_WDN = 25 * MiB, WS_WC2 = 33 * MiB;
constexpr size_t WS_CS = 36 * MiB;
constexpr size_t WS_SSQ = 44 * MiB;
constexpr size_t WS_HP = 50 * MiB;
constexpr size_t WS_QKV = 130 * MiB;
constexpr size_t WS_GATES = 370 * MiB;
constexpr size_t WS_MIXED = 130 * MiB;
constexpr size_t WS_U = 130 * MiB;
constexpr size_t WS_T2 = 130 * MiB;
constexpr size_t WS_END = 498 * MiB;
constexpr int CW_TMO = 0, CW_CODE = 1;
constexpr int CW_BAR = 4096;

constexpr int RING_OFF = 0, RING_BYTES = 131072;
constexpr int LDSCTL_OFF = RING_BYTES, MISC_OFF = LDSCTL_OFF + 320;
constexpr int LDS_BYTES = 147456;

#define GAS __attribute__((address_space(1)))
#define LAS __attribute__((address_space(3)))
typedef unsigned short bf16;
typedef unsigned v4u __attribute__((ext_vector_type(4)));
typedef unsigned v2u __attribute__((ext_vector_type(2)));
typedef float f32x4 __attribute__((ext_vector_type(4)));
typedef float f32x2 __attribute__((ext_vector_type(2)));
typedef GAS unsigned gu32;
#define RLX_AGENT __ATOMIC_RELAXED, __HIP_MEMORY_SCOPE_AGENT
#define LDS_WAIT() asm volatile("s_waitcnt lgkmcnt(0)" ::: "memory")
#define VM_WAIT() asm volatile("s_waitcnt vmcnt(0)" ::: "memory")
__device__ __forceinline__ unsigned f2bf(float f) { unsigned u = __builtin_bit_cast(unsigned, f); return (u + 0x7fffu + ((u >> 16) & 1u)) >> 16; }
__device__ __forceinline__ unsigned pk2(float lo, float hi) { return f2bf(lo) | (f2bf(hi) << 16); }
__device__ __forceinline__ float sigmoidf_(float x) { return __builtin_amdgcn_rcpf(1.f + __expf(-x)); }

#define XB_TMO      128
#define XB_XCNT(j)  (256  + 64 * (j))
#define XB_XSUB(j)  (1280 + 64 * (j))
#define XB_XGEN(j)  (2304 + 64 * (j))
#define XB_TOP      3328
#define XB_TOPGEN   3392
#define XCD_BAR_WORDS 3456
#define XB_SPIN_CAP (1u << 18)

__device__ __forceinline__ unsigned xb_ld(unsigned* p)              { return __hip_atomic_load(p, __ATOMIC_RELAXED, __HIP_MEMORY_SCOPE_AGENT); }
__device__ __forceinline__ unsigned xb_add(unsigned* p, unsigned v) { return __hip_atomic_fetch_add(p, v, __ATOMIC_RELAXED, __HIP_MEMORY_SCOPE_AGENT); }
__device__ __forceinline__ unsigned xb_xcc_id() { return (unsigned)__builtin_amdgcn_s_getreg((3 << 11) | 20) & 0xFu; }
#define XB_SPIN(cond, bar) do { unsigned _sp = 0; while (cond) { __builtin_amdgcn_s_sleep(1); \
    if ((++_sp & 255u) == 0u) { if (xb_ld(&(bar)[XB_TMO])) break; if (_sp > XB_SPIN_CAP) { atomicAdd(&(bar)[XB_TMO], 1u); break; } } } } while (0)

struct XcdBarrier { unsigned* bar; unsigned x; volatile LAS unsigned* st; };

__device__ __forceinline__ XcdBarrier xcd_barrier_post(unsigned* bar, volatile LAS unsigned* st) {
    XcdBarrier b; b.bar = bar; b.x = xb_xcc_id(); b.st = st;
    if (threadIdx.x == 0) (void)xb_add(&bar[XB_XCNT(b.x)], 1u);
    return b;
}
__device__ __forceinline__ void xcd_barrier_complete(unsigned* bar, unsigned x, unsigned& nloc, unsigned& nx) {
    const unsigned G = gridDim.x * gridDim.y * gridDim.z;
    unsigned sum, cnt, mine, sp = 0u;
    for (;;) {
        sum = 0u; cnt = 0u; mine = 0u;
#pragma unroll
        for (unsigned j = 0; j < 16; ++j) { const unsigned c = xb_ld(&bar[XB_XCNT(j)]); sum += c; cnt += (c > 0u) ? 1u : 0u; mine = (j == x) ? c : mine; }
        if (sum == G) break;
        __builtin_amdgcn_s_sleep(1);
        if ((++sp & 255u) == 0u) { if (xb_ld(&bar[XB_TMO])) break; if (sp > XB_SPIN_CAP) { atomicAdd(&bar[XB_TMO], 1u); break; } }
    }
    nloc = mine > 0u ? mine : 1u; nx = cnt > 0u ? cnt : 1u;
}
__device__ __forceinline__ void xcd_barrier(const XcdBarrier& b, const int wave) {
    asm volatile("s_waitcnt vmcnt(0)" ::: "memory");
    __syncthreads();
    if (wave == 0 && pg8::lane_id_now() == 0) {
        unsigned* bar = b.bar;
        __builtin_amdgcn_s_waitcnt(0);
        unsigned nloc = b.st[0], nx = b.st[1];
        if (nloc == 0u) { xcd_barrier_complete(bar, b.x, nloc, nx); b.st[0] = nloc; b.st[1] = nx; }
        const unsigned old = xb_add(&bar[XB_XSUB(b.x)], 1u);
        const unsigned gen = old / nloc;
        if (old + 1u == (gen + 1u) * nloc) {
            __builtin_amdgcn_fence(__ATOMIC_RELEASE, "agent");
            asm volatile("s_waitcnt vmcnt(0)" ::: "memory");
            const unsigned og = xb_add(&bar[XB_TOP], 1u);
            const unsigned tg = og / nx;
            if (og + 1u == (tg + 1u) * nx) xb_add(&bar[XB_TOPGEN], 1u);
            else XB_SPIN(xb_ld(&bar[XB_TOPGEN]) == tg, bar);
            __builtin_amdgcn_fence(__ATOMIC_ACQUIRE, "agent");
            xb_add(&bar[XB_XGEN(b.x)], 1u);
            asm volatile("s_waitcnt vmcnt(0)" ::: "memory");
        } else {
            XB_SPIN(xb_ld(&bar[XB_XGEN(b.x)]) == gen, bar);
            __builtin_amdgcn_fence(__ATOMIC_ACQUIRE, "agent");
            asm volatile("s_waitcnt vmcnt(0)" ::: "memory");
        }
    }
    __syncthreads();
}

using pg8::f32x4; using pg8::u32x4; using pg8::Unit; using pg8::pack8; using pg8::unpack8;
typedef f32x4 acc_t[2][2][4][2];

__device__ __forceinline__ int perm_row(int row, int sh) {
    const int t = row & (SEQ - 1);
    return (row & ~(SEQ - 1)) | ((t & ((1 << sh) - 1)) << (12 - sh)) | (t >> sh);
}

#define EPI_ROW0() unsigned rbase = (unsigned)(u.pm * 256 + wr * 64 + fr); asm volatile("" : "+v"(rbase))

struct EpiIn {
    static constexpr bool PERM = true, HAS_MID = false; static constexpr int MID_T = -1;
    bf16* QKV; bf16* GATES; const float* CS;
    __device__ __forceinline__ void mid(acc_t&, const Unit&, int, int, int, int) const {}
    __device__ __forceinline__ void operator()(const acc_t& acc, const Unit& u, int wr, int wc, int fr, int fq) const {
        const int pn = u.pn; EPI_ROW0();
        if (pn >= 15) {
            const unsigned col0 = (unsigned)((pn - 15) * 256 + wc * 32 + 8 * fq);
#pragma unroll
            for (int ai = 0; ai < 2; ++ai)
#pragma unroll
                for (int m = 0; m < 4; ++m) { const unsigned ro = (rbase + ai * 128 + m * 16) * NGATE + col0;
#pragma unroll
                    for (int bj = 0; bj < 2; ++bj) { f32x4 v0 = acc[ai][bj][m][0], v1 = acc[ai][bj][m][1];
#pragma unroll
                        for (int j = 0; j < 4; ++j) { v0[j] = sigmoidf_(v0[j]); v1[j] = sigmoidf_(v1[j]); }
                        *(u32x4*)(GATES + (ro + bj * 128)) = pack8(v0, v1); } }
        } else if (pn >= 6 && pn < 12) {
            const int g = (pn - 6) % 3, sh = 2 * g; const float sc = pn < 9 ? QSCALE : 1.f;
            const unsigned col0 = (unsigned)(pn * 256 + wc * 64 + 8 * fq);
#pragma unroll
            for (int ai = 0; ai < 2; ++ai)
#pragma unroll
                for (int m = 0; m < 4; ++m) { const unsigned row = rbase + ai * 128 + m * 16; const unsigned ro = (unsigned)perm_row((int)row, sh) * NQKV + col0;
                    const f32x4* cs = (const f32x4*)(CS + (row * 64u + 16u * fq));
                    const f32x4 c01 = cs[0], c23 = cs[1], c45 = cs[2], c67 = cs[3];
                    const float cc[8] = {c01[0], c01[2], c23[0], c23[2], c45[0], c45[2], c67[0], c67[2]};
                    const float ss[8] = {c01[1], c01[3], c23[1], c23[3], c45[1], c45[3], c67[1], c67[3]};
                    f32x4 o1[2], o2[2];
#pragma unroll
                    for (int n = 0; n < 2; ++n)
#pragma unroll
                        for (int j = 0; j < 4; ++j) { const float x1 = acc[ai][0][m][n][j], x2 = acc[ai][1][m][n][j], c = cc[4 * n + j], sn = ss[4 * n + j];
                            o1[n][j] = (x1 * c - x2 * sn) * sc; o2[n][j] = (x2 * c + x1 * sn) * sc; }
                    *(u32x4*)(QKV + ro) = pack8(o1[0], o1[1]); *(u32x4*)(QKV + (ro + 32)) = pack8(o2[0], o2[1]); }
        } else {
            const float sc = pn < 2 ? QSCALE : 1.f; const int sh = pn >= 12 ? 2 * (pn - 12) : 0;
            const unsigned col0 = (unsigned)(pn * 256 + wc * 32 + 8 * fq);
#pragma unroll
            for (int ai = 0; ai < 2; ++ai)
#pragma unroll
                for (int m = 0; m < 4; ++m) { const unsigned row = rbase + ai * 128 + m * 16; const unsigned ro = (unsigned)perm_row((int)row, sh) * NQKV + col0;
#pragma unroll
                    for (int bj = 0; bj < 2; ++bj) *(u32x4*)(QKV + (ro + bj * 128)) = pack8(acc[ai][bj][m][0] * sc, acc[ai][bj][m][1] * sc); }
        }
    }
};

struct EpiMix {
    static constexpr bool PERM = true, HAS_MID = true; static constexpr int MID_T = 8;
    const bf16* GATES; bf16* MIXED;
    __device__ __forceinline__ void mid(acc_t& acc, const Unit& u, int wr, int wc, int fr, int fq) const {
        EPI_ROW0(); const unsigned col0 = (unsigned)(u.pn * 256 + wc * 32 + 8 * fq);
#pragma unroll
        for (int ai = 0; ai < 2; ++ai)
#pragma unroll
            for (int m = 0; m < 4; ++m) { const unsigned ro = (rbase + ai * 128 + m * 16) * NGATE + col0;
#pragma unroll
                for (int bj = 0; bj < 2; ++bj) { f32x4 a0, a1, b0, b1; unpack8(*(const u32x4*)(GATES + (ro + bj * 128)), a0, a1); unpack8(*(const u32x4*)(GATES + (ro + bj * 128 + 1024)), b0, b1);
#pragma unroll
                    for (int j = 0; j < 4; ++j) { acc[ai][bj][m][0][j] *= a0[j] * __builtin_amdgcn_rcpf(fmaxf(b0[j], 1e-30f)); acc[ai][bj][m][1][j] *= a1[j] * __builtin_amdgcn_rcpf(fmaxf(b1[j], 1e-30f)); } } }
    }
    __device__ __forceinline__ void operator()(const acc_t& acc, const Unit& u, int wr, int wc, int fr, int fq) const {
        EPI_ROW0(); const unsigned col0 = (unsigned)(u.pn * 256 + wc * 32 + 8 * fq);
#pragma unroll
        for (int ai = 0; ai < 2; ++ai)
#pragma unroll
            for (int m = 0; m < 4; ++m) { const unsigned row = rbase + ai * 128 + m * 16; const unsigned go = row * NGATE + 1024 + col0, oo = row * DM + col0;
#pragma unroll
                for (int bj = 0; bj < 2; ++bj) { f32x4 b0, b1; unpack8(*(const u32x4*)(GATES + (go + bj * 128)), b0, b1);
                    *(u32x4*)(MIXED + (oo + bj * 128)) = pack8(acc[ai][bj][m][0] * b0, acc[ai][bj][m][1] * b1); } }
    }
};

struct EpiRes {
    static constexpr bool PERM = true, HAS_MID = false; static constexpr int MID_T = -1;
    const float* base; float* out; bf16* HB; float* ssq;
    __device__ __forceinline__ void mid(acc_t&, const Unit&, int, int, int, int) const {}
    __device__ __forceinline__ void operator()(const acc_t& acc, const Unit& u, int wr, int wc, int fr, int fq) const {
        EPI_ROW0(); const unsigned col0 = (unsigned)(u.pn * 256 + wc * 32 + 8 * fq);
#pragma unroll
        for (int ai = 0; ai < 2; ++ai)
#pragma unroll
            for (int m = 0; m < 4; ++m) { const unsigned row = rbase + ai * 128 + m * 16; float s = 0.f;
#pragma unroll
                for (int bj = 0; bj < 2; ++bj) { const unsigned off = row * DM + col0 + bj * 128;
                    const f32x4 v0 = *(const f32x4*)(base + off) + acc[ai][bj][m][0], v1 = *(const f32x4*)(base + (off + 4)) + acc[ai][bj][m][1];
                    *(f32x4*)(out + off) = v0; *(f32x4*)(out + (off + 4)) = v1;
                    s += (v0[0] * v0[0] + v0[1] * v0[1]) + (v0[2] * v0[2] + v0[3] * v0[3]) + (v1[0] * v1[0] + v1[1] * v1[1]) + (v1[2] * v1[2] + v1[3] * v1[3]);
                    *(u32x4*)(HB + (row * HPW + col0 + bj * 128)) = pack8(v0, v1); }
                s += __shfl_xor(s, 16); s += __shfl_xor(s, 32);
                if (fq == 0) ssq[row * 16 + u.pn * 4 + wc] = s; }
    }
};

__device__ __forceinline__ float row_rstd(const float* ssq, unsigned row) {
    const f32x4* p = (const f32x4*)(ssq + row * 16u); const f32x4 a = p[0], b = p[1], c = p[2], d = p[3];
    const float s = ((a[0] + a[1]) + (a[2] + a[3])) + ((b[0] + b[1]) + (b[2] + b[3])) + ((c[0] + c[1]) + (c[2] + c[3])) + ((d[0] + d[1]) + (d[2] + d[3]));
    return 1.0f / sqrtf(s * (1.0f / DM) + RMS_EPS);
}

struct EpiUp {
    static constexpr bool PERM = true, HAS_MID = false; static constexpr int MID_T = -1;
    const float* ssq; bf16* U;
    __device__ __forceinline__ void mid(acc_t&, const Unit&, int, int, int, int) const {}
    __device__ __forceinline__ void operator()(const acc_t& acc, const Unit& u, int wr, int wc, int fr, int fq) const {
        EPI_ROW0(); const unsigned col0 = (unsigned)(u.pn * 256 + wc * 32 + 8 * fq);
#pragma unroll
        for (int ai = 0; ai < 2; ++ai)
#pragma unroll
            for (int m = 0; m < 4; ++m) { const unsigned row = rbase + ai * 128 + m * 16; const float r = row_rstd(ssq, row); const unsigned oo = row * DFF + col0;
#pragma unroll
                for (int bj = 0; bj < 2; ++bj) { f32x4 v0 = acc[ai][bj][m][0] * r, v1 = acc[ai][bj][m][1] * r;
#pragma unroll
                    for (int j = 0; j < 4; ++j) { const float a = fmaxf(v0[j], 0.f), b = fmaxf(v1[j], 0.f); v0[j] = a * a; v1[j] = b * b; }
                    *(u32x4*)(U + (oo + bj * 128)) = pack8(v0, v1); } }
    }
};

struct EpiPle {
    static constexpr bool PERM = true, HAS_MID = true; static constexpr int MID_T = 4;
    bf16* T2; const float* ssq_in; float* out; float* ssq_out;
    __device__ __forceinline__ void mid(acc_t& acc, const Unit& u, int wr, int wc, int fr, int fq) const {
        EPI_ROW0(); const unsigned col0 = (unsigned)(u.pn * 256 + wc * 32 + 8 * fq);
#pragma unroll
        for (int ai = 0; ai < 2; ++ai)
#pragma unroll
            for (int m = 0; m < 4; ++m) { const unsigned to = (rbase + ai * 128 + m * 16) * DM + col0;
#pragma unroll
                for (int bj = 0; bj < 2; ++bj) { *(u32x4*)(T2 + (to + bj * 128)) = pack8(acc[ai][bj][m][0], acc[ai][bj][m][1]);
                    acc[ai][bj][m][0] = (f32x4){0.f, 0.f, 0.f, 0.f}; acc[ai][bj][m][1] = (f32x4){0.f, 0.f, 0.f, 0.f}; } }
    }
    __device__ __forceinline__ void operator()(const acc_t& acc, const Unit& u, int wr, int wc, int fr, int fq) const {
        EPI_ROW0(); const unsigned col0 = (unsigned)(u.pn * 256 + wc * 32 + 8 * fq);
#pragma unroll
        for (int ai = 0; ai < 2; ++ai)
#pragma unroll
            for (int m = 0; m < 4; ++m) { const unsigned row = rbase + ai * 128 + m * 16; const float r = row_rstd(ssq_in, row); float s = 0.f;
#pragma unroll
                for (int bj = 0; bj < 2; ++bj) { const unsigned off = row * DM + col0 + bj * 128;
                    f32x4 t0, t1; unpack8(*(const u32x4*)(T2 + off), t0, t1);
                    f32x4 v0 = *(const f32x4*)(out + off), v1 = *(const f32x4*)(out + (off + 4));
#pragma unroll
                    for (int j = 0; j < 4; ++j) { v0[j] += sigmoidf_(acc[ai][bj][m][0][j] * r) * t0[j]; v1[j] += sigmoidf_(acc[ai][bj][m][1][j] * r) * t1[j]; }
                    *(f32x4*)(out + off) = v0; *(f32x4*)(out + (off + 4)) = v1;
                    s += (v0[0] * v0[0] + v0[1] * v0[1]) + (v0[2] * v0[2] + v0[3] * v0[3]) + (v1[0] * v1[0] + v1[1] * v1[1]) + (v1[2] * v1[2] + v1[3] * v1[3]); }
                s += __shfl_xor(s, 16); s += __shfl_xor(s, 32);
                if (fq == 0) ssq_out[row * 16 + u.pn * 4 + wc] = s; }
    }
};

struct Frame {
    LAS unsigned char* lds;
    volatile LAS unsigned* MISC;
    gu32* ctl;
    int wave;
    int vcu, G;
    const float *x, *p, *g_mix, *w_in, *rpb, *w_bna, *w_bdil, *w_out, *g_mlp, *w_up, *w_down, *g_ple, *w_pg, *w_pp, *g_final; const int* positions;
    float* out;
    bf16 *Win_t, *Wc1_t, *Wo_t, *Wup_t, *Wdn_t, *Wc2_t;
    float* CS; float* SSQ;
    bf16 *HP, *QKV, *GATES, *MIXED, *U, *T2;
};

__device__ __forceinline__ float wave_sum(float v) {
#pragma unroll
    for (int o = 1; o < 64; o <<= 1) v += __shfl_xor(v, o);
    return v;
}
__device__ __forceinline__ void tr_item(const float* W, int N, int k0, int src_n0, bf16* WT, int ldo, int orow0, int kofs, const float* gk, LAS float* scr, int lane) {
#pragma unroll 8
    for (int i = 0; i < 32; ++i) { const int kk = 2 * i + (lane >> 5); const float gg = gk ? gk[k0 + kk] : 1.f; scr[kk * 33 + (lane & 31)] = W[(size_t)(k0 + kk) * N + src_n0 + (lane & 31)] * gg; }
    LDS_WAIT(); asm volatile("" ::: "memory");
    const int c = lane & 7;
#pragma unroll
    for (int j = 0; j < 4; ++j) { const int n = (lane >> 3) + 8 * j; const LAS float* s = scr + (8 * c) * 33 + n;
        v4u o; o.x = pk2(s[0 * 33], s[1 * 33]); o.y = pk2(s[2 * 33], s[3 * 33]); o.z = pk2(s[4 * 33], s[5 * 33]); o.w = pk2(s[6 * 33], s[7 * 33]);
        *(GAS v4u*)(WT + (size_t)(orow0 + n) * ldo + kofs + k0 + 8 * c) = o; }
    LDS_WAIT(); asm volatile("" ::: "memory");
}
__device__ __forceinline__ void tr_plain(const float* W, int K, int N, bf16* WT, int ldo, int kofs, const float* gk, LAS float* scr, int item, int lane) {
    const int nblk = N / 32, kb = item / nblk, nb = item % nblk;
    tr_item(W, N, 64 * kb, 32 * nb, WT, ldo, 32 * nb, kofs, gk, scr, lane);
}
__device__ __forceinline__ void tr_win(const float* W, bf16* WT, LAS float* scr, int item, int lane) {
    const int nblk = NIN / 32, kb = item / nblk, nb = item % nblk, n0 = 32 * nb, pn = n0 >> 8, v = n0 & 255;
    const int src = (pn >= 6 && pn < 12) ? (pn * 256 + 64 * ((v & 127) >> 5) + 32 * (v >> 7)) : n0;
    tr_item(W, NIN, 64 * kb, src, WT, DM, n0, 0, nullptr, scr, lane);
}

struct Args { const void* in[16]; float* out; unsigned char* ws; double inv_freq[32]; int ph_lo, ph_hi, li, pad; };

__device__ __forceinline__ void sincos_rev(double ang, float& c, float& s) {
    const double TWO_PI = 6.283185307179586476925286766559;
    const double n = rint(ang * (1.0 / TWO_PI)); const double r = ang - n * TWO_PI, r2 = r * r;
    double sn = 1.0 / 51090942171709440000.0;
    sn = sn * r2 - 1.0 / 121645100408832000.0;
    sn = sn * r2 + 1.0 / 355687428096000.0;
    sn = sn * r2 - 1.0 / 1307674368000.0;
    sn = sn * r2 + 1.0 / 6227020800.0;
    sn = sn * r2 - 1.0 / 39916800.0;
    sn = sn * r2 + 1.0 / 362880.0;
    sn = sn * r2 - 1.0 / 5040.0;
    sn = sn * r2 + 1.0 / 120.0;
    sn = sn * r2 - 1.0 / 6.0;
    sn = sn * r2 + 1.0; sn *= r;
    double cs = 1.0 / 2432902008176640000.0;
    cs = cs * r2 - 1.0 / 6402373705728000.0;
    cs = cs * r2 + 1.0 / 20922789888000.0;
    cs = cs * r2 - 1.0 / 87178291200.0;
    cs = cs * r2 + 1.0 / 479001600.0;
    cs = cs * r2 - 1.0 / 3628800.0;
    cs = cs * r2 + 1.0 / 40320.0;
    cs = cs * r2 - 1.0 / 720.0;
    cs = cs * r2 + 1.0 / 24.0;
    cs = cs * r2 - 0.5;
    cs = cs * r2 + 1.0;
    c = (float)cs; s = (float)sn;
}

__device__ __forceinline__ void p0_prologue(Frame& F, const Args& args) {
    LAS float* scr = (LAS float*)(F.lds + RING_OFF + F.wave * 16384);
    const int gw = F.vcu * NWAVES + F.wave, NGW = F.G * NWAVES, lane = pg8::lane_id_now(), tid = F.wave * 64 + lane;
    constexpr int I_IN = (DM / 64) * (NIN / 32), I_A = (512 / 64) * (DM / 32), I_B = (256 / 64) * (DM / 32), I_O = (DM / 64) * (DM / 32), I_UP = (DM / 64) * (DFF / 32), I_DN = (DFF / 64) * (DM / 32), I_PP = (PLE / 64) * (DM / 32), I_PG = I_O;
    constexpr int NITEMS = I_IN + I_A + I_B + I_O + I_UP + I_DN + I_PP + I_PG;
    for (int it = gw; it < NITEMS; it += NGW) {
        int r = it;
        if (r < I_IN) { tr_win(F.w_in, F.Win_t, scr, r, lane); continue; } r -= I_IN;
        if (r < I_A) { tr_plain(F.w_bna, 512, DM, F.Wc1_t, YW, 0, nullptr, scr, r, lane); continue; } r -= I_A;
        if (r < I_B) { tr_plain(F.w_bdil, 256, DM, F.Wc1_t, YW, 512, nullptr, scr, r, lane); continue; } r -= I_B;
        if (r < I_O) { tr_plain(F.w_out, DM, DM, F.Wo_t, DM, 0, nullptr, scr, r, lane); continue; } r -= I_O;
        if (r < I_UP) { tr_plain(F.w_up, DM, DFF, F.Wup_t, DM, 0, F.g_mlp, scr, r, lane); continue; } r -= I_UP;
        if (r < I_DN) { tr_plain(F.w_down, DFF, DM, F.Wdn_t, DFF, 0, nullptr, scr, r, lane); continue; } r -= I_DN;
        if (r < I_PP) { tr_plain(F.w_pp, PLE, DM, F.Wc2_t, HPW, 0, nullptr, scr, r, lane); continue; } r -= I_PP;
        tr_plain(F.w_pg, DM, DM, F.Wc2_t, HPW, PLE, F.g_ple, scr, r, lane);
    }
    for (int m = gw; m < M; m += NGW) {
        const GAS f32x4* xr = (const GAS f32x4*)(F.x + (size_t)m * DM) + lane;
        f32x4 v[4]; float s = 0.f;
#pragma unroll
        for (int j = 0; j < 4; ++j) { v[j] = xr[64 * j]; s += (v[j].x * v[j].x + v[j].y * v[j].y) + (v[j].z * v[j].z + v[j].w * v[j].w); }
        const float rstd = 1.0f / sqrtf(wave_sum(s) * (1.f / DM) + RMS_EPS);
        GAS v2u* o8 = (GAS v2u*)(F.HP + (size_t)m * HPW + PLE) + lane;
#pragma unroll
        for (int j = 0; j < 4; ++j) { const f32x4 gg = *((const GAS f32x4*)F.g_mix + lane + 64 * j);
            v2u w; w.x = pk2(v[j].x * rstd * gg.x, v[j].y * rstd * gg.y); w.y = pk2(v[j].z * rstd * gg.z, v[j].w * rstd * gg.w); o8[64 * j] = w; }
        const f32x4 pv = *((const GAS f32x4*)(F.p + (size_t)m * PLE) + lane);
        v2u w; w.x = pk2(pv.x, pv.y); w.y = pk2(pv.z, pv.w); *((GAS v2u*)(F.HP + (size_t)m * HPW) + lane) = w;
    }
    { const long gt = (long)F.vcu * (NWAVES * 64) + tid, NT = (long)F.G * NWAVES * 64;
      for (long e = gt; e < (long)M * 32; e += NT) { const int row = (int)(e >> 5), f = (int)(e & 31);
          float c, s; sincos_rev((double)F.positions[row] * args.inv_freq[f], c, s);
          *(GAS f32x2*)(F.CS + e * 2) = (f32x2){c, s}; } }
}

__device__ __forceinline__ void ld8f(const bf16* p, float (&f)[8]) { const v4u v = *(const GAS v4u*)p;
    f[0] = pg8::bf_lo(v.x); f[1] = pg8::bf_hi(v.x); f[2] = pg8::bf_lo(v.y); f[3] = pg8::bf_hi(v.y); f[4] = pg8::bf_lo(v.z); f[5] = pg8::bf_hi(v.z); f[6] = pg8::bf_lo(v.w); f[7] = pg8::bf_hi(v.w); }

__device__ __forceinline__ void attn_naive(Frame& F) {
    const long gt = (long)F.vcu * (NWAVES * 64) + F.wave * 64 + pg8::lane_id_now(), NT = (long)F.G * NWAVES * 64;
    for (long item = gt; item < (long)M * 8; item += NT) {
        const int h = (int)(item & 7), tok = (int)(item >> 3);
        const int b = tok >> 12, t = tok & 4095, r = t >> 6, c = t & 63;
        const int rs = min(max(r - 4, 0), 56), cs = min(max(c - 8, 0), 48);
        float q[64], o[64];
        { const bf16* qp = F.QKV + (size_t)tok * NQKV + h * 64;
#pragma unroll
          for (int ch = 0; ch < 8; ++ch) { float f[8]; ld8f(qp + ch * 8, f);
#pragma unroll
              for (int e = 0; e < 8; ++e) { q[ch * 8 + e] = f[e]; o[ch * 8 + e] = 0.f; } } }
        float mx = -1e30f, l = 0.f;
        for (int kk = 0; kk < 128; ++kk) {
            const int kr = rs + (kk >> 4), kc = cs + (kk & 15);
            const bf16* kp = F.QKV + (size_t)((b << 12) + kr * 64 + kc) * NQKV + 512 + h * 64;
            float s = 0.f;
#pragma unroll
            for (int ch = 0; ch < 8; ++ch) { float f[8]; ld8f(kp + ch * 8, f);
#pragma unroll
                for (int e = 0; e < 8; ++e) s += q[ch * 8 + e] * f[e]; }
            s += LOG2E * F.rpb[h * 465 + (kr - r + 7) * 31 + (kc - c + 15)];
            const float mn = fmaxf(mx, s), a = exp2f(mx - mn), pw = exp2f(s - mn);
            l = l * a + pw; mx = mn;
            const bf16* vp = kp + 512;
#pragma unroll
            for (int ch = 0; ch < 8; ++ch) { float f[8]; ld8f(vp + ch * 8, f);
#pragma unroll
                for (int e = 0; e < 8; ++e) o[ch * 8 + e] = o[ch * 8 + e] * a + pw * f[e]; }
        }
        const float il = 1.f / l; bf16* yp = F.HP + (size_t)tok * HPW + PLE + h * 64;
#pragma unroll
        for (int ch = 0; ch < 8; ++ch) { v4u w; w.x = pk2(o[ch * 8 + 0] * il, o[ch * 8 + 1] * il); w.y = pk2(o[ch * 8 + 2] * il, o[ch * 8 + 3] * il); w.z = pk2(o[ch * 8 + 4] * il, o[ch * 8 + 5] * il); w.w = pk2(o[ch * 8 + 6] * il, o[ch * 8 + 7] * il);
            *(GAS v4u*)(yp + ch * 8) = w; }
    }
    for (long item = gt; item < (long)M * 4; item += NT) {
        const int slot = (int)(item & 3), tok = (int)(item >> 2);
        const int b = tok >> 12, t = tok & 4095;
        float q[64], o[64];
#pragma unroll
        for (int e = 0; e < 64; ++e) o[e] = 0.f;
        float mx = -1e30f, l = 0.f;
        for (int g = 0; g < 3; ++g) {
            const int sh = 2 * g, L = SEQ >> sh, rho = t & ((1 << sh) - 1), i = t >> sh, rowbase = (b << 12) + rho * L, hc = (g * 4 + slot) * 64;
            { const bf16* qp = F.QKV + (size_t)(rowbase + i) * NQKV + 1536 + hc;
#pragma unroll
              for (int ch = 0; ch < 8; ++ch) { float f[8]; ld8f(qp + ch * 8, f);
#pragma unroll
                  for (int e = 0; e < 8; ++e) q[ch * 8 + e] = f[e]; } }
            const int j0 = max(0, i - 64), j1 = min(L - 1, i + 64);
            for (int j = j0; j <= j1; ++j) {
                const bf16* kp = F.QKV + (size_t)(rowbase + j) * NQKV + 2304 + hc;
                float s = 0.f;
#pragma unroll
                for (int ch = 0; ch < 8; ++ch) { float f[8]; ld8f(kp + ch * 8, f);
#pragma unroll
                    for (int e = 0; e < 8; ++e) s += q[ch * 8 + e] * f[e]; }
                const float mn = fmaxf(mx, s), a = exp2f(mx - mn), pw = exp2f(s - mn);
                l = l * a + pw; mx = mn;
                const bf16* vp = kp + 768;
#pragma unroll
                for (int ch = 0; ch < 8; ++ch) { float f[8]; ld8f(vp + ch * 8, f);
#pragma unroll
                    for (int e = 0; e < 8; ++e) o[ch * 8 + e] = o[ch * 8 + e] * a + pw * f[e]; }
            }
        }
        const float il = 1.f / l; bf16* yp = F.HP + (size_t)tok * HPW + PLE + 512 + slot * 64;
#pragma unroll
        for (int ch = 0; ch < 8; ++ch) { v4u w; w.x = pk2(o[ch * 8 + 0] * il, o[ch * 8 + 1] * il); w.y = pk2(o[ch * 8 + 2] * il, o[ch * 8 + 3] * il); w.z = pk2(o[ch * 8 + 4] * il, o[ch * 8 + 5] * il); w.w = pk2(o[ch * 8 + 6] * il, o[ch * 8 + 7] * il);
            *(GAS v4u*)(yp + ch * 8) = w; }
    }
}


namespace at {
typedef float f32x16 __attribute__((ext_vector_type(16)));
typedef short bf16x8 __attribute__((ext_vector_type(8)));
typedef short s16x4 __attribute__((ext_vector_type(4)));
constexpr int BIAS_LDS = 0, BIAS_BYTES = 8 * 15 * 64 * 4, VBUF_LDS = 32768, VBUF_BYTES = 4096;
constexpr float NEG = -1e30f, M_INIT = -30000.f;
__device__ __forceinline__ s16x4 vtr(const LAS unsigned char* p) { return __builtin_bit_cast(s16x4, __builtin_amdgcn_ds_read_tr16_b64_v4i16((LAS s16x4*)p)); }
__device__ __forceinline__ float hswap_max(float v) { auto rr = __builtin_amdgcn_permlane32_swap(__float_as_uint(v), __float_as_uint(v), false, false); return fmaxf(__uint_as_float(rr[0]), __uint_as_float(rr[1])); }
__device__ __forceinline__ float hswap_sum(float v) { auto rr = __builtin_amdgcn_permlane32_swap(__float_as_uint(v), __float_as_uint(v), false, false); return __uint_as_float(rr[0]) + __uint_as_float(rr[1]); }
#define AT_OFF(r) (((r) & 3) + 8 * ((r) >> 2))

struct State { f32x16 o0, o1; float m, l; };

__device__ __forceinline__ void load_k(bf16x8 (&kf)[4], const bf16* p) {
#pragma unroll
    for (int s2 = 0; s2 < 4; ++s2) kf[s2] = *(const GAS bf16x8*)(p + 8 * s2); }
__device__ __forceinline__ void load_v(v4u (&vr)[4], const bf16* p) {
#pragma unroll
    for (int i = 0; i < 4; ++i) vr[i] = *(const GAS v4u*)(p + (size_t)i * 8 * NQKV); }
__device__ __forceinline__ void store_v(LAS unsigned char* vw, const v4u (&vr)[4]) {
#pragma unroll
    for (int i = 0; i < 4; ++i) *(LAS v4u*)(vw + 512 * i) = vr[i]; }

__device__ __forceinline__ void softmax_pv(f32x16& S, State& st, const LAS unsigned char* vrd) {
    float mt = fmaxf(fmaxf(S[0], S[1]), fmaxf(S[2], S[3]));
#pragma unroll
    for (int r = 4; r < 16; r += 4) mt = fmaxf(mt, fmaxf(fmaxf(S[r], S[r + 1]), fmaxf(S[r + 2], S[r + 3])));
    mt = hswap_max(mt);
    const float mn = fmaxf(st.m, mt);
    if (__any(mn > st.m)) { const float alpha = __builtin_amdgcn_exp2f(st.m - mn); st.l *= alpha; st.o0 = st.o0 * alpha; st.o1 = st.o1 * alpha; st.m = mn; }
    const float negm = -st.m; float ls = 0.f;
#pragma unroll
    for (int r = 0; r < 16; ++r) { S[r] = __builtin_amdgcn_exp2f(S[r] + negm); ls += S[r]; }
    st.l += ls;
    v4u pw0, pw1;
    pw0.x = pg8::cvt_pk_bf16(S[0], S[1]); pw0.y = pg8::cvt_pk_bf16(S[2], S[3]); pw0.z = pg8::cvt_pk_bf16(S[4], S[5]); pw0.w = pg8::cvt_pk_bf16(S[6], S[7]);
    pw1.x = pg8::cvt_pk_bf16(S[8], S[9]); pw1.y = pg8::cvt_pk_bf16(S[10], S[11]); pw1.z = pg8::cvt_pk_bf16(S[12], S[13]); pw1.w = pg8::cvt_pk_bf16(S[14], S[15]);
    const bf16x8 pb0 = __builtin_bit_cast(bf16x8, pw0), pb1 = __builtin_bit_cast(bf16x8, pw1);
#pragma unroll
    for (int blk = 0; blk < 2; ++blk) {
        const s16x4 a0 = vtr(vrd + blk * 2048), a1 = vtr(vrd + blk * 2048 + 512), b0 = vtr(vrd + blk * 2048 + 1024), b1 = vtr(vrd + blk * 2048 + 1536);
        const bf16x8 va = (bf16x8){a0[0], a0[1], a0[2], a0[3], a1[0], a1[1], a1[2], a1[3]}, vb = (bf16x8){b0[0], b0[1], b0[2], b0[3], b1[0], b1[1], b1[2], b1[3]};
        if (blk == 0) { st.o0 = __builtin_amdgcn_mfma_f32_32x32x16_bf16(va, pb0, st.o0, 0, 0, 0); st.o0 = __builtin_amdgcn_mfma_f32_32x32x16_bf16(vb, pb1, st.o0, 0, 0, 0); }
        else          { st.o1 = __builtin_amdgcn_mfma_f32_32x32x16_bf16(va, pb0, st.o1, 0, 0, 0); st.o1 = __builtin_amdgcn_mfma_f32_32x32x16_bf16(vb, pb1, st.o1, 0, 0, 0); }
    }
}
__device__ __forceinline__ f32x16 qk(const bf16x8 (&kf)[4], const bf16x8 (&qf)[4]) {
    f32x16 S = {0.f, 0.f, 0.f, 0.f, 0.f, 0.f, 0.f, 0.f, 0.f, 0.f, 0.f, 0.f, 0.f, 0.f, 0.f, 0.f};
#pragma unroll
    for (int s2 = 0; s2 < 4; ++s2) S = __builtin_amdgcn_mfma_f32_32x32x16_bf16(kf[s2], qf[s2], S, 0, 0, 0);
    return S;
}
__device__ __forceinline__ void store_o(bf16* dst  , const State& st, float scale, int hi) {
#pragma unroll
    for (int blk = 0; blk < 2; ++blk)
#pragma unroll
        for (int g4 = 0; g4 < 4; ++g4) { const f32x16& o = blk ? st.o1 : st.o0;
            v2u w; w.x = pg8::cvt_pk_bf16(o[4 * g4] * scale, o[4 * g4 + 1] * scale); w.y = pg8::cvt_pk_bf16(o[4 * g4 + 2] * scale, o[4 * g4 + 3] * scale);
            *(GAS v2u*)(dst + 32 * blk + 8 * g4 + 4 * hi) = w; }
}

__device__ __forceinline__ void na_tile(const bf16* QKV, bf16* HPy, LAS unsigned char* lds, int wave, int lane, int b, int h, int r0, int cb) {
    const int q = lane & 31, hi = lane >> 5, qr = r0 + (q >> 4), qc = 16 * cb + (q & 15);
    const int rs_q = min(max(qr - 4, 0), 56), cs_q = min(max(qc - 8, 0), 48), kc0 = min(max(16 * cb - 8, 0), 32);
    const int krA = min(max(r0 - 4, 0), 56), nt = min(max(r0 - 3, 0), 56) + 8 - krA;
    const int qrow = (b << 12) + qr * 64 + qc;
    bf16x8 qf[4]; load_k(qf, QKV + (size_t)qrow * NQKV + h * 64 + 32 * hi);
    float cadj[16];
#pragma unroll
    for (int r = 0; r < 16; ++r) cadj[r] = ((unsigned)(kc0 + 4 * hi + AT_OFF(r) - cs_q) < 16u) ? 0.f : NEG;
    LAS unsigned char* vbuf = lds + VBUF_LDS + wave * VBUF_BYTES;
    LAS unsigned char* vw = vbuf + ((lane & 7) >> 2) * 2048 + (lane >> 3) * 64 + (lane & 3) * 16;
    const LAS unsigned char* vrd = vbuf + (4 * hi + ((lane & 15) >> 2)) * 64 + ((lane >> 4) & 1) * 32 + (lane & 3) * 8;
    const LAS float* btab = (const LAS float*)(lds + BIAS_LDS) + h * 960 + (kc0 + 4 * hi - qc + 31);
    const int row0 = (b << 12) + krA * 64 + kc0;
    const bf16* kp = QKV + (size_t)(row0 + q) * NQKV + 512 + h * 64 + 32 * hi;
    const bf16* vp = QKV + (size_t)(row0 + (lane >> 3)) * NQKV + 1024 + h * 64 + 8 * (lane & 7);
    State st; st.m = M_INIT; st.l = 0.f;
#pragma unroll
    for (int r = 0; r < 16; ++r) { st.o0[r] = 0.f; st.o1[r] = 0.f; }
    bf16x8 kf[4]; v4u vr[4]; load_k(kf, kp); load_v(vr, vp);
    for (int t = 0; t < nt; ++t) {
        const int kr = krA + t;
        store_v(vw, vr);
        bf16x8 kc[4];
#pragma unroll
        for (int s2 = 0; s2 < 4; ++s2) kc[s2] = kf[s2];
        if (t + 1 < nt) { kp += (size_t)64 * NQKV; vp += (size_t)64 * NQKV; load_k(kf, kp); load_v(vr, vp); }
        f32x16 S = qk(kc, qf);
        const LAS float* bt = btab + (kr - qr + 7) * 64;
        const float radj = (kr >= rs_q && kr < rs_q + 8) ? 0.f : NEG;
#pragma unroll
        for (int r = 0; r < 16; ++r) S[r] = S[r] + (bt[AT_OFF(r)] + (cadj[r] + radj));
        softmax_pv(S, st, vrd);
    }
    const float lt = hswap_sum(st.l);
    store_o(HPy + (size_t)qrow * HPW + h * 64, st, 1.0f / lt, hi);
}

__device__ __forceinline__ void dil_tile(const bf16* QKV, LAS unsigned char* lds, int wave, int lane, int seqbase, int L, int i0, int hc, State& st) {
    const int q = lane & 31, hi = lane >> 5;
    bf16x8 qf[4]; load_k(qf, QKV + (size_t)(seqbase + i0 + q) * NQKV + 1536 + hc + 32 * hi);
    LAS unsigned char* vbuf = lds + VBUF_LDS + wave * VBUF_BYTES;
    LAS unsigned char* vw = vbuf + ((lane & 7) >> 2) * 2048 + (lane >> 3) * 64 + (lane & 3) * 16;
    const LAS unsigned char* vrd = vbuf + (4 * hi + ((lane & 15) >> 2)) * 64 + ((lane >> 4) & 1) * 32 + (lane & 3) * 8;
    const int jlo = max(i0 - 64, 0), jhi = min(i0 + 96, L);
    const bf16* kp = QKV + (size_t)(seqbase + jlo + q) * NQKV + 2304 + hc + 32 * hi;
    const bf16* vp = QKV + (size_t)(seqbase + jlo + (lane >> 3)) * NQKV + 3072 + hc + 8 * (lane & 7);
    st.m = M_INIT; st.l = 0.f;
#pragma unroll
    for (int r = 0; r < 16; ++r) { st.o0[r] = 0.f; st.o1[r] = 0.f; }
    bf16x8 kf[4]; v4u vr[4]; load_k(kf, kp); load_v(vr, vp);
    for (int j0 = jlo; j0 < jhi; j0 += 32) {
        store_v(vw, vr);
        bf16x8 kc[4];
#pragma unroll
        for (int s2 = 0; s2 < 4; ++s2) kc[s2] = kf[s2];
        if (j0 + 32 < jhi) { kp += (size_t)32 * NQKV; vp += (size_t)32 * NQKV; load_k(kf, kp); load_v(vr, vp); }
        f32x16 S = qk(kc, qf);
        const int dj = j0 - i0;
        if (dj == -64) {
#pragma unroll
            for (int r = 0; r < 16; ++r) S[r] = (AT_OFF(r) + 4 * hi >= q) ? S[r] : NEG;
        } else if (dj == 64) {
#pragma unroll
            for (int r = 0; r < 16; ++r) S[r] = (AT_OFF(r) + 4 * hi <= q) ? S[r] : NEG;
        }
        softmax_pv(S, st, vrd);
    }
    st.l = hswap_sum(st.l);
}

__device__ __forceinline__ void attn_phase(Frame& F) {
    const int lane = pg8::lane_id_now(), wave = F.wave, tid = wave * 64 + lane, q = lane & 31, hi = lane >> 5;
    LAS unsigned char* lds = F.lds + RING_OFF;
    for (int i = tid; i < 8 * 15 * 64; i += NWAVES * 64) { const int hh = i / 960, rem = i % 960, d7 = rem >> 6, dc = (rem & 63) - 31;
        ((LAS float*)(lds + BIAS_LDS))[i] = (dc >= -15 && dc <= 15) ? LOG2E * F.rpb[hh * 465 + d7 * 31 + dc + 15] : 0.f; }
    __syncthreads();
    bf16* O1 = (bf16*)F.out; bf16* O2 = O1 + (size_t)M * 256; float* L1 = (float*)((unsigned char*)F.out + 32 * MiB); float* L2 = L1 + (size_t)M * 4;
    bf16* HPy = F.HP + PLE;
    for (int unit = F.vcu; unit < 256; unit += F.G) {
        const int b = unit >> 5, slot = (unit >> 3) & 3, T0 = (unit & 7) * 512;
        for (int a = wave; a < 32; a += NWAVES) {
            int sh, rho, i0;
            if (a < 16) { sh = 2; rho = a & 3; i0 = (T0 >> 2) + 32 * (a >> 2); } else { sh = 4; rho = a - 16; i0 = T0 >> 4; }
            const int L = SEQ >> sh, g = sh >> 1;
            State st; dil_tile(F.QKV, lds, wave, lane, (b << 12) + rho * L, L, i0, (g * 4 + slot) * 64, st);
            const int tok = (b << 12) + ((i0 + q) << sh) + rho;
            store_o((g == 1 ? O1 : O2) + (size_t)tok * 256 + slot * 64, st, 1.0f / st.l, hi);
            if (hi == 0) (g == 1 ? L1 : L2)[(size_t)tok * 4 + slot] = st.m + __builtin_amdgcn_logf(st.l);
        }
        { const int bh = unit >> 2, nb = bh >> 3, nh = bh & 7, r0 = 16 * (unit & 3) + 2 * wave;
          for (int cb = 0; cb < 4; ++cb) na_tile(F.QKV, HPy, lds, wave, lane, nb, nh, r0, cb); }
        asm volatile("s_waitcnt vmcnt(0)" ::: "memory");
        __syncthreads();
        __builtin_amdgcn_fence(__ATOMIC_ACQUIRE, "agent");
        for (int c = wave; c < 16; c += NWAVES) {
            const int i0 = T0 + 32 * c;
            State st; dil_tile(F.QKV, lds, wave, lane, (b << 12), SEQ, i0, slot * 64, st);
            const int tok = (b << 12) + i0 + q;
            const float l0 = st.m + __builtin_amdgcn_logf(st.l), l1 = L1[(size_t)tok * 4 + slot], l2 = L2[(size_t)tok * 4 + slot];
            const float mx = fmaxf(l0, fmaxf(l1, l2)), w0 = __builtin_amdgcn_exp2f(l0 - mx), w1 = __builtin_amdgcn_exp2f(l1 - mx), w2 = __builtin_amdgcn_exp2f(l2 - mx);
            const float iw = 1.0f / (w0 + w1 + w2), s0 = w0 * iw / st.l, s1 = w1 * iw, s2 = w2 * iw;
            const bf16* p1 = O1 + (size_t)tok * 256 + slot * 64; const bf16* p2 = O2 + (size_t)tok * 256 + slot * 64; bf16* yp = HPy + (size_t)tok * HPW + 512 + slot * 64;
#pragma unroll
            for (int blk = 0; blk < 2; ++blk)
#pragma unroll
                for (int g4 = 0; g4 < 4; ++g4) { const f32x16& o = blk ? st.o1 : st.o0; const int d = 32 * blk + 8 * g4 + 4 * hi;
                    const v2u a1 = *(const GAS v2u*)(p1 + d), a2 = *(const GAS v2u*)(p2 + d);
                    const float y0 = o[4 * g4] * s0 + pg8::bf_lo(a1.x) * s1 + pg8::bf_lo(a2.x) * s2, y1 = o[4 * g4 + 1] * s0 + pg8::bf_hi(a1.x) * s1 + pg8::bf_hi(a2.x) * s2;
                    const float y2 = o[4 * g4 + 2] * s0 + pg8::bf_lo(a1.y) * s1 + pg8::bf_lo(a2.y) * s2, y3 = o[4 * g4 + 3] * s0 + pg8::bf_hi(a1.y) * s1 + pg8::bf_hi(a2.y) * s2;
                    v2u w; w.x = pg8::cvt_pk_bf16(y0, y1); w.y = pg8::cvt_pk_bf16(y2, y3); *(GAS v2u*)(yp + d) = w; }
        }
        __syncthreads();
    }
}
#undef AT_OFF
}

__device__ __forceinline__ void final_norm(Frame& F) {
    const int gw = F.vcu * NWAVES + F.wave, NGW = F.G * NWAVES, lane = pg8::lane_id_now();
    const float* ssq = F.SSQ + 2 * (size_t)M * 16;
    for (int m = gw; m < M; m += NGW) {
        const float r = row_rstd(ssq, (unsigned)m);
        GAS f32x4* xr = (GAS f32x4*)(F.out + (size_t)m * DM) + lane;
#pragma unroll
        for (int j = 0; j < 4; ++j) { const f32x4 gg = *((const GAS f32x4*)F.g_final + lane + 64 * j); f32x4 v = xr[64 * j]; v = v * r * gg; xr[64 * j] = v; }
    }
}


#ifdef MK_CHECK
constexpr size_t WS_SAVE = 498 * MiB;
constexpr int CW_CHK = 8192;
constexpr int NSAMP = 512;
__device__ __forceinline__ int samp_row(int s) { return 64 * s + ((s * 37) & 63); }
__device__ __forceinline__ float bfr(float f) { return __uint_as_float(f2bf(f) << 16); }
__device__ __forceinline__ float bfv(const bf16* p) { return __uint_as_float((unsigned)(*p) << 16); }
__device__ __forceinline__ void chk_report(gu32* ctl, int phase, float got, float exp, int s, int col) {
    const float dev = fabsf(got - exp) / (0.02f + 0.02f * fabsf(exp));
    const unsigned long long v = ((unsigned long long)__float_as_uint(dev) << 32) | (unsigned)((s << 13) | col);
    atomicMax((unsigned long long*)(ctl + CW_CHK + 2 * phase), v);
}
__device__ __forceinline__ float row_rstd_direct(const float* h) { float s = 0.f; for (int k = 0; k < DM; ++k) s += h[k] * h[k]; return 1.0f / sqrtf(s * (1.f / DM) + RMS_EPS); }
__global__ void __launch_bounds__(256) chk_kernel(Args args, int phase) {
    unsigned char* ws = args.ws; gu32* ctl = (gu32*)(ws + WS_CTL);
    const float* x = (const float*)args.in[0]; const float* pin = (const float*)args.in[1]; const int* positions = (const int*)args.in[2]; const float* g_mix = (const float*)args.in[3]; const float* w_in = (const float*)args.in[4];
    const float* w_bna = (const float*)args.in[6]; const float* w_bdil = (const float*)args.in[7]; const float* w_out = (const float*)args.in[8]; const float* g_mlp = (const float*)args.in[9];
    const float* w_up = (const float*)args.in[10]; const float* w_down = (const float*)args.in[11]; const float* g_ple = (const float*)args.in[12]; const float* w_pg = (const float*)args.in[13]; const float* w_pp = (const float*)args.in[14]; const float* g_final = (const float*)args.in[15];
    const bf16* HP = (const bf16*)(ws + WS_HP); const bf16* QKV = (const bf16*)(ws + WS_QKV); const bf16* GATES = (const bf16*)(ws + WS_GATES); const bf16* MIXED = (const bf16*)(ws + WS_MIXED); const bf16* U = (const bf16*)(ws + WS_U);
    float* SAVE = (float*)(ws + WS_SAVE); const float* out = args.out;
    const long gt = (long)blockIdx.x * 256 + threadIdx.x, NT = (long)gridDim.x * 256;
    if (phase == 100) {
        for (long e = gt; e < (long)NSAMP * DM; e += NT) { const int s = (int)(e >> 10), c = (int)(e & 1023); SAVE[e] = out[(size_t)samp_row(s) * DM + c]; }
    } else if (phase == 0) {
        for (long e = gt; e < (long)NSAMP * HPW; e += NT) { const int s = (int)(e / HPW), c = (int)(e % HPW), row = samp_row(s);
            float exp; if (c < PLE) exp = pin[(size_t)row * PLE + c]; else { const float r = row_rstd_direct(x + (size_t)row * DM); exp = x[(size_t)row * DM + c - PLE] * r * g_mix[c - PLE]; }
            chk_report(ctl, 0, bfv(HP + (size_t)row * HPW + c), exp, s, c); }
    } else if (phase == 1) {
        for (long e = gt; e < (long)NSAMP * NIN; e += NT) { const int s = (int)(e / NIN), c = (int)(e % NIN), row = samp_row(s);
            const bf16* a = HP + (size_t)row * HPW + PLE;
            float v = 0.f, v2 = 0.f; const bool rot = (c >= 1536 && c < 3072); const int c2 = rot ? (c ^ 32) : c;
            for (int k = 0; k < DM; ++k) { const float av = bfv(a + k); v += av * bfr(w_in[(size_t)k * NIN + c]); if (rot) v2 += av * bfr(w_in[(size_t)k * NIN + c2]); }
            float exp, got;
            if (c >= 3840) { exp = 1.f / (1.f + expf(-v)); got = bfv(GATES + (size_t)row * NGATE + (c - 3840)); }
            else { int sh = 0; if (c >= 1536) sh = 2 * (((c - 1536) % 768) / 256);
                if (rot) { const int d = c & 63, f = d & 31; const double ang = (double)positions[row] * args.inv_freq[f]; const float cs = (float)cos(ang), sn = (float)sin(ang);
                    exp = (d < 32) ? (v * cs - v2 * sn) : (v * cs + v2 * sn); if (c < 2304) exp *= QSCALE; }
                else exp = (c < 512) ? v * QSCALE : v;
                got = bfv(QKV + (size_t)perm_row(row, sh) * NQKV + c); }
            chk_report(ctl, 1, got, exp, s, c); }
    } else if (phase == 3) {
        for (long e = gt; e < (long)NSAMP * DM; e += NT) { const int s = (int)(e >> 10), c = (int)(e & 1023), row = samp_row(s);
            const bf16* y = HP + (size_t)row * HPW + PLE; float t1 = 0.f, t2 = 0.f;
            for (int k = 0; k < 512; ++k) t1 += bfv(y + k) * bfr(w_bna[(size_t)k * DM + c]);
            for (int k = 0; k < 256; ++k) t2 += bfv(y + 512 + k) * bfr(w_bdil[(size_t)k * DM + c]);
            const float exp = bfv(GATES + (size_t)row * NGATE + c) * t1 + bfv(GATES + (size_t)row * NGATE + 1024 + c) * t2;
            chk_report(ctl, 3, bfv(MIXED + (size_t)row * DM + c), exp, s, c); }
    } else if (phase == 4) {
        for (long e = gt; e < (long)NSAMP * DM; e += NT) { const int s = (int)(e >> 10), c = (int)(e & 1023), row = samp_row(s);
            float v = 0.f; for (int k = 0; k < DM; ++k) v += bfv(MIXED + (size_t)row * DM + k) * bfr(w_out[(size_t)k * DM + c]);
            chk_report(ctl, 4, out[(size_t)row * DM + c], x[(size_t)row * DM + c] + v, s, c); }
    } else if (phase == 5) {
        for (long e = gt; e < (long)NSAMP * DFF; e += NT) { const int s = (int)(e >> 12), c = (int)(e & 4095), row = samp_row(s);
            const float r = row_rstd_direct(out + (size_t)row * DM); float v = 0.f;
            for (int k = 0; k < DM; ++k) v += bfv(HP + (size_t)row * HPW + PLE + k) * bfr(w_up[(size_t)k * DFF + c] * g_mlp[k]);
            v = fmaxf(v * r, 0.f); chk_report(ctl, 5, bfv(U + (size_t)row * DFF + c), v * v, s, c); }
    } else if (phase == 6) {
        for (long e = gt; e < (long)NSAMP * DM; e += NT) { const int s = (int)(e >> 10), c = (int)(e & 1023), row = samp_row(s);
            float v = 0.f; for (int k = 0; k < DFF; ++k) v += bfv(U + (size_t)row * DFF + k) * bfr(w_down[(size_t)k * DM + c]);
            chk_report(ctl, 6, out[(size_t)row * DM + c], SAVE[e] + v, s, c); }
    } else if (phase == 7) {
        for (long e = gt; e < (long)NSAMP * DM; e += NT) { const int s = (int)(e >> 10), c = (int)(e & 1023), row = samp_row(s);
            const float r = row_rstd_direct(SAVE + (size_t)s * DM); float v = 0.f, t = 0.f;
            for (int k = 0; k < DM; ++k) v += bfv(HP + (size_t)row * HPW + PLE + k) * bfr(w_pg[(size_t)k * DM + c] * g_ple[k]);
            for (int k = 0; k < PLE; ++k) t += bfv(HP + (size_t)row * HPW + k) * bfr(w_pp[(size_t)k * DM + c]);
            chk_report(ctl, 7, out[(size_t)row * DM + c], SAVE[e] + t / (1.f + expf(-v * r)), s, c); }
    } else if (phase == 8) {
        for (long e = gt; e < (long)NSAMP * DM; e += NT) { const int s = (int)(e >> 10), c = (int)(e & 1023), row = samp_row(s);
            const float r = row_rstd_direct(SAVE + (size_t)s * DM); chk_report(ctl, 8, out[(size_t)row * DM + c], SAVE[e] * r * g_final[c], s, c); }
    } else if (phase == 300) {
        unsigned nq = 0, ng = 0;
        for (long e = gt; e < (long)M * NQKV; e += NT) nq += (QKV[e] == 0xAAAAu) ? 1u : 0u;
        for (long e = gt; e < (long)M * NGATE; e += NT) { if (GATES[e] == 0xAAAAu) { ng += 1u; atomicOr((unsigned*)(ctl + CW_CHK + 43), (unsigned)(e & 2047)); atomicAnd((unsigned*)(ctl + CW_CHK + 44), (unsigned)(e & 2047)); atomicMax((unsigned*)(ctl + CW_CHK + 42), (unsigned)(e >> 11)); } }
        if (nq) atomicAdd((unsigned*)(ctl + CW_CHK + 39), nq); if (ng) atomicAdd((unsigned*)(ctl + CW_CHK + 40), ng);
    } else if (phase == 200) {
        if (gt == 0) { int d1 = 9, d2 = 0, E = 3;
            for (int ph = 0; ph < 9; ++ph) { const unsigned long long v = *((unsigned long long*)(ctl + CW_CHK + 2 * ph)); const float dev = __uint_as_float((unsigned)(v >> 32));
                if (dev > 1.f) { d1 = ph; const int lg = (int)floorf(log2f(dev)); d2 = lg > 9 ? 9 : lg; const unsigned loc = (unsigned)v;
#if MK_CHECK == 1
                    E = 3 + (int)((loc & 8191) >> 8);
#elif MK_CHECK == 2
                    E = 3 + (int)(((loc & 8191) & 255) >> 4);
#elif MK_CHECK == 3
                    E = 3 + (int)((loc >> 13) >> 5);
#else
                    E = 3 + (int)((loc >> 13) & 31);
#endif
                    break; } }
            float X = (float)(10 * d1 + d2); for (int i = 0; i < E; ++i) X *= 10.f;
#if MK_CHECK >= 5
            { const unsigned long long v = *((unsigned long long*)(ctl + CW_CHK + 2 * 1)); const unsigned loc = (unsigned)v; const int s_ = (int)(loc >> 13), c_ = (int)(loc & 8191), row_ = samp_row(s_);
              const float got_ = bfv(GATES + (size_t)row_ * NGATE + (c_ - 3840));
#if MK_CHECK == 5
              { const unsigned ng_ = *(unsigned*)(ctl + CW_CHK + 40), nq_ = *(unsigned*)(ctl + CW_CHK + 39); X = (float)(31 - __clz((int)(ng_ + 1u)) + 10); const int E_ = 3 + 31 - __clz((int)(nq_ + 1u)); for (int i = 0; i < E_; ++i) X *= 10.f; }
#elif MK_CHECK == 6
              X = (float)(*(unsigned*)(ctl + CW_CHK + 42)) * 1e10f;
#elif MK_CHECK == 7
              X = (float)(*(unsigned*)(ctl + CW_CHK + 43)) * 1e10f;
#else
              X = __uint_as_float((unsigned)(v >> 32)) * 1e10f;
#endif
            }
#endif
            ((float*)args.out)[0] = X; }
    }
}
#endif

__global__ void __launch_bounds__(NWAVES * 64, 2) skel_fwd(Args args) {
    extern __shared__ __attribute__((aligned(16))) unsigned char lds[];
    Frame F;
    F.lds = (LAS unsigned char*)lds;
    F.MISC = (volatile LAS unsigned*)(F.lds + MISC_OFF);
    F.wave = __builtin_amdgcn_readfirstlane((int)threadIdx.x >> 6);
    F.G = gridDim.x; { const int bx = blockIdx.x; F.vcu = (F.G % 8 == 0) ? (bx % 8) * (F.G / 8) + bx / 8 : bx; }
#define GRID_BAR(seam) do { if (N_LAUNCHES == PER_PHASE) { if (F.wave == 0 && pg8::lane_id_now() == 0) __hip_atomic_store(F.ctl + CW_TMO, 0xBADBA0u | (unsigned)(seam), RLX_AGENT); } \
    else { xcd_barrier(bar, F.wave); } } while (0)
    unsigned char* ws = args.ws;
    F.ctl = (gu32*)(ws + WS_CTL);
    F.x = (const float*)args.in[0]; F.p = (const float*)args.in[1]; F.positions = (const int*)args.in[2]; F.g_mix = (const float*)args.in[3]; F.w_in = (const float*)args.in[4];
    F.rpb = (const float*)args.in[5]; F.w_bna = (const float*)args.in[6]; F.w_bdil = (const float*)args.in[7]; F.w_out = (const float*)args.in[8]; F.g_mlp = (const float*)args.in[9];
    F.w_up = (const float*)args.in[10]; F.w_down = (const float*)args.in[11]; F.g_ple = (const float*)args.in[12]; F.w_pg = (const float*)args.in[13]; F.w_pp = (const float*)args.in[14]; F.g_final = (const float*)args.in[15];
    F.out = args.out;
    F.Win_t = (bf16*)(ws + WS_WIN); F.Wc1_t = (bf16*)(ws + WS_WC1); F.Wo_t = (bf16*)(ws + WS_WO); F.Wup_t = (bf16*)(ws + WS_WUP); F.Wdn_t = (bf16*)(ws + WS_WDN); F.Wc2_t = (bf16*)(ws + WS_WC2);
    F.CS = (float*)(ws + WS_CS); F.SSQ = (float*)(ws + WS_SSQ);
    F.HP = (bf16*)(ws + WS_HP); F.QKV = (bf16*)(ws + WS_QKV); F.GATES = (bf16*)(ws + WS_GATES); F.MIXED = (bf16*)(ws + WS_MIXED); F.U = (bf16*)(ws + WS_U); F.T2 = (bf16*)(ws + WS_T2);
    for (int u = (int)threadIdx.x; u < (LDS_BYTES - LDSCTL_OFF) / 4; u += NWAVES * 64) ((LAS unsigned*)(F.lds + LDSCTL_OFF))[u] = 0u;
    __syncthreads();
    const int bli = (N_LAUNCHES == PER_PHASE) ? 0 : args.li;
    XcdBarrier bar; bar.bar = (unsigned*)(F.ctl + CW_BAR) + bli * XCD_BAR_WORDS; bar.x = 0; bar.st = nullptr;
    if (N_LAUNCHES != PER_PHASE)
        bar = xcd_barrier_post((unsigned*)(F.ctl + CW_BAR) + bli * XCD_BAR_WORDS, F.MISC + 8);

    const int lo = args.ph_lo, hi = args.ph_hi;
#define IN(k) (lo <= (k) && (k) < hi)
#define BOTH(k) (IN(k) && IN((k) + 1))
    const int cid = (int)blockIdx.x;

    if (IN(0)) { p0_prologue(F, args); if (BOTH(0)) GRID_BAR(0); }

    if (IN(1)) {
        pg8::Gemm g{F.HP + PLE, F.Win_t, M, NIN, DM, HPW}; pg8::StaticOrder S; S.init(M, NIN, F.G, cid);
        EpiIn E{F.QKV, F.GATES, F.CS};
        pg8::gemm_phase<EpiIn, pg8::StaticOrder, PG8_ALIGN, PG8_SP2>(F.lds + RING_OFF, g, S, E, F.wave);
        if (BOTH(1)) GRID_BAR(1);
    }
    if (IN(2)) {
#ifdef ATTN_NAIVE
        attn_naive(F);
#else
        at::attn_phase(F);
#endif
        if (BOTH(2)) GRID_BAR(2); }
    if (IN(3)) {
        pg8::Gemm g{F.HP + PLE, F.Wc1_t, M, DM, YW, HPW}; pg8::StaticOrder S; S.init(M, DM, F.G, cid);
        EpiMix E{F.GATES, F.MIXED};
        pg8::gemm_phase<EpiMix, pg8::StaticOrder, PG8_ALIGN, PG8_SP2>(F.lds + RING_OFF, g, S, E, F.wave);
        if (BOTH(3)) GRID_BAR(3);
    }
    if (IN(4)) {
        pg8::Gemm g{F.MIXED, F.Wo_t, M, DM, DM, DM}; pg8::StaticOrder S; S.init(M, DM, F.G, cid);
        EpiRes E{F.x, F.out, F.HP + PLE, F.SSQ};
        pg8::gemm_phase<EpiRes, pg8::StaticOrder, PG8_ALIGN, PG8_SP2>(F.lds + RING_OFF, g, S, E, F.wave);
        if (BOTH(4)) GRID_BAR(4);
    }
    if (IN(5)) {
        pg8::Gemm g{F.HP + PLE, F.Wup_t, M, DFF, DM, HPW}; pg8::StaticOrder S; S.init(M, DFF, F.G, cid);
        EpiUp E{F.SSQ, F.U};
        pg8::gemm_phase<EpiUp, pg8::StaticOrder, PG8_ALIGN, PG8_SP2>(F.lds + RING_OFF, g, S, E, F.wave);
        if (BOTH(5)) GRID_BAR(5);
    }
    if (IN(6)) {
        pg8::Gemm g{F.U, F.Wdn_t, M, DM, DFF, DFF}; pg8::StaticOrder S; S.init(M, DM, F.G, cid);
        EpiRes E{F.out, F.out, F.HP + PLE, F.SSQ + (size_t)M * 16};
        pg8::gemm_phase<EpiRes, pg8::StaticOrder, PG8_ALIGN, PG8_SP2>(F.lds + RING_OFF, g, S, E, F.wave);
        if (BOTH(6)) GRID_BAR(6);
    }
    if (IN(7)) {
        pg8::Gemm g{F.HP, F.Wc2_t, M, DM, HPW, HPW}; pg8::StaticOrder S; S.init(M, DM, F.G, cid);
        EpiPle E{F.T2, F.SSQ + (size_t)M * 16, F.out, F.SSQ + 2 * (size_t)M * 16};
        pg8::gemm_phase<EpiPle, pg8::StaticOrder, PG8_ALIGN, PG8_SP2>(F.lds + RING_OFF, g, S, E, F.wave);
        if (BOTH(7)) GRID_BAR(7);
    }
    if (IN(8)) { final_norm(F); }
#undef IN
#undef BOTH
}

extern "C" void kernel_launch(void* const* d_in, const int* in_sizes, int n_in, void* d_out, int out_size, void* d_ws, size_t ws_size, hipStream_t stream) {
    static int grid = 0;
    if (grid == 0) {
        if (n_in != 16 || in_sizes[0] != M * DM || out_size != M * DM || ws_size < WS_END) { fprintf(stderr, "kernel_launch: shape/workspace mismatch: n_in %d in0 %d out %d ws %zu (need %zu); nothing launched\n", n_in, n_in > 0 ? in_sizes[0] : -1, out_size, ws_size, (size_t)WS_END); grid = -1; return; }
        int dev = 0, cus = 0, per_cu = 0;
        if (hipGetDevice(&dev) != hipSuccess || hipDeviceGetAttribute(&cus, hipDeviceAttributeMultiprocessorCount, dev) != hipSuccess) { fprintf(stderr, "kernel_launch: device query failed\n"); grid = -1; return; }
        if (hipFuncSetAttribute((const void*)skel_fwd, hipFuncAttributeMaxDynamicSharedMemorySize, LDS_BYTES) != hipSuccess) { fprintf(stderr, "kernel_launch: hipFuncSetAttribute failed\n"); grid = -1; return; }
        if (hipOccupancyMaxActiveBlocksPerMultiprocessor(&per_cu, (const void*)skel_fwd, NWAVES * 64, LDS_BYTES) != hipSuccess || per_cu < 1)
            fprintf(stderr, "kernel_launch: note: occupancy query reports %d workgroups per CU\n", per_cu);
        (void)hipGetLastError();
        grid = cus;
    }
    if (grid < 0) return;
#ifdef MK_CHECK
    (void)hipMemsetAsync((char*)d_ws + WS_QKV, 0xAA, 368 * MiB, stream);
#endif
    if (hipMemsetAsync((char*)d_ws + WS_CTL, 0, CTL_ZERO_BYTES, stream) != hipSuccess) { fprintf(stderr, "kernel_launch: hipMemsetAsync failed\n"); return; }
    Args a{};
    for (int i = 0; i < 16; ++i) a.in[i] = d_in[i];
    a.out = (float*)d_out; a.ws = (unsigned char*)d_ws;
    for (int f = 0; f < 32; ++f) a.inv_freq[f] = std::pow(10000.0, -(double)f / 32.0);
    static_assert(N_LAUNCHES == 1 || N_LAUNCHES == PER_PHASE, "MK_N_LAUNCHES is 1 or 9");
    for (int li = 0; li < N_LAUNCHES; ++li) {
        a.ph_lo = (N_LAUNCHES == PER_PHASE) ? li : 0; a.ph_hi = (N_LAUNCHES == PER_PHASE) ? li + 1 : PER_PHASE; a.li = (N_LAUNCHES == PER_PHASE) ? 0 : li;
        hipLaunchKernelGGL(skel_fwd, dim3(grid), dim3(NWAVES * 64), LDS_BYTES, stream, a);
        const hipError_t le = hipPeekAtLastError();
        if (le != hipSuccess) { fprintf(stderr, "kernel_launch: launch %d failed: %s\n", li, hipGetErrorName(le)); break; }
#ifdef MK_CHECK
        if (li == 0 || li == 1 || li == 3 || li == 4 || li == 5 || li == 6 || li == 7 || li == 8) hipLaunchKernelGGL(chk_kernel, dim3(1024), dim3(256), 0, stream, a, li);
        if (li == 1) hipLaunchKernelGGL(chk_kernel, dim3(1024), dim3(256), 0, stream, a, 300);
        if (li == 5 || li == 6 || li == 7) hipLaunchKernelGGL(chk_kernel, dim3(1024), dim3(256), 0, stream, a, 100);
        if (li == 8) hipLaunchKernelGGL(chk_kernel, dim3(1), dim3(256), 0, stream, a, 200);
#endif
    }
}
```
